# Optimizing an MI355X kernel written in HIP

```python
import math
import jax, jax.numpy as jnp
from jax import lax
import numpy as np

D_MODEL = 1024
BATCH = 8
SEQ = 2048
DEPTH = 1
DEC_BATCH = 128
DEC_SEQ = 8
PAST_LEN = 16384
PAGE_SIZE = 128

D_MIX = D_MODEL
POOL_WIDTH = D_MIX // 2
POOL_WINDOWS = (2, 4, 8, 16)
N_POOL_GROUPS = len(POOL_WINDOWS)
POOL_GROUP = POOL_WIDTH // N_POOL_GROUPS
POOL_BUF = max(POOL_WINDOWS) - 1
GLA_WIDTH = D_MIX - POOL_WIDTH
GLA_HEADS = 4
GLA_HEAD_V = GLA_WIDTH // GLA_HEADS
GLA_HEAD_K = GLA_HEAD_V // 2
GLA_KEY = GLA_HEADS * GLA_HEAD_K
GLA_GATE_RANK = 16
GLA_GATE_NORM = 16.0
GLA_CHUNK = 64
IN_SIZES = (POOL_WIDTH, GLA_KEY, GLA_KEY, GLA_WIDTH, GLA_GATE_RANK, GLA_WIDTH)
D_IN = sum(IN_SIZES)
D_FF = 2816
N_ADA = 9
EPS = 1e-6

kernel_name = "hymba_pool_gla_macaron_adaln_step"


def rms_norm(x, g):
    x32 = x.astype(jnp.float32)
    y = x32 * lax.rsqrt(jnp.mean(x32 * x32, axis=-1, keepdims=True) + EPS)
    return (y * g.astype(jnp.float32)).astype(x.dtype)


def modulate(h, shift, scale):
    return h * (1 + scale) + shift


def swiglu(h, w_up, w_down):
    g, u = jnp.split(h @ w_up, 2, axis=-1)
    return (jax.nn.silu(g) * u) @ w_down


def split_in(proj):
    outs, off = [], 0
    for s in IN_SIZES:
        outs.append(proj[..., off:off + s])
        off += s
    return outs


def pool_mixer(u, buf, pos0, w_pool, pool_scale):
    B, T, P = u.shape
    ext = jnp.concatenate([buf.astype(u.dtype), u], axis=1).astype(jnp.float32)
    cs = jnp.concatenate([jnp.zeros((B, 1, P), jnp.float32), jnp.cumsum(ext, axis=1)], axis=1)
    pos = pos0 + jnp.arange(T, dtype=jnp.int32)
    cur = ext[:, POOL_BUF:, :]
    outs = []
    for g, w in enumerate(POOL_WINDOWS):
        lo, hi = g * POOL_GROUP, (g + 1) * POOL_GROUP
        win = cs[:, POOL_BUF + 1:POOL_BUF + 1 + T, lo:hi] - cs[:, POOL_BUF + 1 - w:POOL_BUF + 1 - w + T, lo:hi]
        cnt = jnp.minimum(pos + 1, w).astype(jnp.float32)[None, :, None]
        p = win / cnt - cur[:, :, lo:hi]
        outs.append(p @ w_pool[g].astype(jnp.float32))
    z = jnp.concatenate(outs, axis=-1) * pool_scale.astype(jnp.float32)
    new_buf = ext[:, -POOL_BUF:, :]
    return z.astype(u.dtype), new_buf


def gla_mixer(q, k, v, log_a, S0):
    B, T, H, dk = q.shape
    C = math.gcd(T, GLA_CHUNK)
    N = T // C

    def blk(t):
        return t.reshape(B, N, C, H, t.shape[-1]).transpose(0, 3, 1, 2, 4)

    q, k, v, log_a = blk(q), blk(k), blk(v), blk(log_a)
    b = jnp.cumsum(log_a, axis=3)
    b_last = b[:, :, :, -1:, :]
    q_in = q * jnp.exp(b) * (dk ** -0.5)
    k_in = k * jnp.exp(-b)
    k_dec = k * jnp.exp(b_last - b)
    mask = jnp.tril(jnp.ones((C, C), dtype=bool))
    att = jnp.where(mask, jnp.einsum('bhncd,bhnsd->bhncs', q_in, k_in), 0.0)
    o = jnp.einsum('bhncs,bhnse->bhnce', att, v)
    upd = jnp.einsum('bhnsd,bhnse->bhnde', k_dec, v)
    decay = jnp.exp(b_last[:, :, :, 0, :])

    def step(S, xs):
        dec, u = xs
        return dec[..., None] * S + u, S

    S_fin, S_prev = lax.scan(step, S0, (jnp.moveaxis(decay, 2, 0), jnp.moveaxis(upd, 2, 0)))
    S_prev = jnp.moveaxis(S_prev, 0, 2)
    o = o + jnp.einsum('bhncd,bhnde->bhnce', q_in, S_prev)
    o = o.transpose(0, 2, 3, 1, 4).reshape(B, T, H, v.shape[-1])
    return o, S_fin


def layer(x, c, pool_buf, gla_S, pos0, ln1, ln_mix, ln2, w_ada, b_ada, w_f1_up, w_f1_down,
          w_in, w_gk2, b_gk2, w_pool, pool_scale, gla_norm, w_out, w_f2_up, w_f2_down):
    B, T, _ = x.shape
    ada = jax.nn.silu(c) @ w_ada + b_ada
    sh1, sc1, g1, shm, scm, gm, sh2, sc2, g2 = [a[:, None, :] for a in jnp.split(ada, N_ADA, axis=-1)]
    h = modulate(rms_norm(x, ln1), sh1, sc1)
    x = x + 0.5 * g1 * swiglu(h, w_f1_up, w_f1_down)
    h = modulate(rms_norm(x, ln_mix), shm, scm)
    u, q, k, v, glr, og = split_in(h @ w_in)
    z_pool, new_buf = pool_mixer(u, pool_buf, pos0, w_pool, pool_scale)
    log_a = jax.nn.log_sigmoid((glr @ w_gk2 + b_gk2).astype(jnp.float32)) / GLA_GATE_NORM
    f32 = jnp.float32
    o, S_new = gla_mixer(q.reshape(B, T, GLA_HEADS, GLA_HEAD_K).astype(f32),
                         k.reshape(B, T, GLA_HEADS, GLA_HEAD_K).astype(f32),
                         v.reshape(B, T, GLA_HEADS, GLA_HEAD_V).astype(f32),
                         log_a.reshape(B, T, GLA_HEADS, GLA_HEAD_K),
                         gla_S.astype(f32))
    o = rms_norm(o, gla_norm).reshape(B, T, GLA_WIDTH) * jax.nn.silu(og.astype(f32))
    mix = jnp.concatenate([z_pool, o.astype(x.dtype)], axis=-1) @ w_out
    x = x + gm * mix
    h = modulate(rms_norm(x, ln2), sh2, sc2)
    x = x + 0.5 * g2 * swiglu(h, w_f2_up, w_f2_down)
    return x, new_buf.astype(x.dtype), S_new.astype(x.dtype)


def setup_inputs(seed: int = 0) -> dict:
    key = jax.random.key(seed)
    ks = jax.random.split(key, 24)

    def nrm(k, shape, scale=1.0):
        return jax.random.normal(k, shape, jnp.float32) * scale

    return {
        "x_prompt": nrm(ks[0], (BATCH, SEQ, D_MODEL)),
        "x_sample": nrm(ks[1], (DEC_BATCH, DEC_SEQ, D_MODEL)),
        "state_pool": nrm(ks[2], (DEPTH, DEC_BATCH, POOL_BUF, POOL_WIDTH)),
        "state_gla": nrm(ks[3], (DEPTH, DEC_BATCH, GLA_HEADS, GLA_HEAD_K, GLA_HEAD_V), 0.5),
        "c_prompt": nrm(ks[4], (BATCH, D_MODEL)),
        "c_sample": nrm(ks[5], (DEC_BATCH, D_MODEL)),
        "ln_ffn1": 1.0 + nrm(ks[6], (DEPTH, D_MODEL), 0.05),
        "ln_mix": 1.0 + nrm(ks[7], (DEPTH, D_MODEL), 0.05),
        "ln_ffn2": 1.0 + nrm(ks[8], (DEPTH, D_MODEL), 0.05),
        "w_ada": nrm(ks[9], (DEPTH, D_MODEL, N_ADA * D_MODEL), 0.5 * D_MODEL ** -0.5),
        "b_ada": nrm(ks[10], (DEPTH, N_ADA * D_MODEL), 0.01),
        "w_ffn1_up": nrm(ks[11], (DEPTH, D_MODEL, 2 * D_FF), D_MODEL ** -0.5),
        "w_ffn1_down": nrm(ks[12], (DEPTH, D_FF, D_MODEL), D_FF ** -0.5),
        "w_in": nrm(ks[13], (DEPTH, D_MODEL, D_IN), D_MODEL ** -0.5),
        "w_gk2": nrm(ks[14], (DEPTH, GLA_GATE_RANK, GLA_KEY), GLA_GATE_RANK ** -0.5),
        "b_gk2": nrm(ks[15], (DEPTH, GLA_KEY), 0.1),
        "w_pool": nrm(ks[16], (DEPTH, N_POOL_GROUPS, POOL_GROUP, POOL_GROUP), POOL_GROUP ** -0.5),
        "pool_scale": 1.0 + nrm(ks[17], (DEPTH, POOL_WIDTH), 0.1),
        "gla_norm": 1.0 + nrm(ks[18], (DEPTH, GLA_HEAD_V), 0.05),
        "w_out": nrm(ks[19], (DEPTH, D_MIX, D_MODEL), D_MIX ** -0.5),
        "w_ffn2_up": nrm(ks[20], (DEPTH, D_MODEL, 2 * D_FF), D_MODEL ** -0.5),
        "w_ffn2_down": nrm(ks[21], (DEPTH, D_FF, D_MODEL), D_FF ** -0.5),
        "ln_final": 1.0 + nrm(ks[22], (D_MODEL,), 0.05),
    }


def reference(x_prompt, x_sample, state_pool, state_gla, c_prompt, c_sample,
              ln_ffn1, ln_mix, ln_ffn2, w_ada, b_ada, w_ffn1_up, w_ffn1_down,
              w_in, w_gk2, b_gk2, w_pool, pool_scale, gla_norm, w_out,
              w_ffn2_up, w_ffn2_down, ln_final):
    bp = x_prompt.shape[0]
    xp, xs = x_prompt, x_sample
    pool_p, gla_p, pool_s, gla_s = [], [], [], []
    for l in range(DEPTH):
        w = (ln_ffn1[l], ln_mix[l], ln_ffn2[l], w_ada[l], b_ada[l], w_ffn1_up[l], w_ffn1_down[l],
             w_in[l], w_gk2[l], b_gk2[l], w_pool[l], pool_scale[l], gla_norm[l], w_out[l],
             w_ffn2_up[l], w_ffn2_down[l])
        buf0 = jnp.zeros((bp, POOL_BUF, POOL_WIDTH), xp.dtype)
        S0 = jnp.zeros((bp, GLA_HEADS, GLA_HEAD_K, GLA_HEAD_V), jnp.float32)
        xp, nb_p, ns_p = layer(xp, c_prompt, buf0, S0, 0, *w)
        xs, nb_s, ns_s = layer(xs, c_sample, state_pool[l], state_gla[l], PAST_LEN, *w)
        pool_p.append(nb_p); gla_p.append(ns_p); pool_s.append(nb_s); gla_s.append(ns_s)
    y_prompt = rms_norm(xp, ln_final)
    y_sample = rms_norm(xs, ln_final)
    new_pool_prompt = jnp.stack(pool_p)
    new_gla_prompt = jnp.stack(gla_p)
    new_pool_sample = jnp.stack(pool_s)
    new_gla_sample = jnp.stack(gla_s)
    return (y_prompt, y_sample, new_pool_prompt, new_gla_prompt, new_pool_sample, new_gla_sample)
```

```cpp
#include <hip/hip_runtime.h>
#include <cstdio>
#include <cstdint>
#ifndef DIAG
#define DIAG 0
#endif
namespace pg8 {
#define PG8_LAS __attribute__((address_space(3)))
typedef unsigned short bf16_t;
typedef short bf16x8 __attribute__((ext_vector_type(8)));
typedef float f32x4 __attribute__((ext_vector_type(4)));
typedef unsigned u32x4 __attribute__((ext_vector_type(4)));
constexpr int BM = 256, BK = 64, HALF = 128, HTB = HALF * BK * 2  , STAGE_BYTES = 8 * HTB, NXCD = 8, WGM = 8;

__host__ __device__ __forceinline__ int lds_byte(int r, int c) { const int st = (r >> 4) * 2 + (c >> 5), rr = r & 15, cc = c & 31, ob = rr * 64 + cc * 2; return st * 1024 + (ob ^ (((ob >> 9) & 1) << 5)); }
__host__ __device__ __forceinline__ void stage_rc(int b, int& R, int& C) { const int st = b / 1024, sb = b % 1024, swz = sb ^ (((sb >> 9) & 1) << 5); R = (st >> 1) * 16 + swz / 64; C = (st & 1) * 32 + (swz % 64) / 2; }
__host__ __device__ __forceinline__ int perm32(int rho) { const int n = rho >> 4, i = rho & 15; return 8 * (i >> 2) + 4 * n + (i & 3); }

struct Unit { int pm, pn; };
struct Gemm { const bf16_t* A; const bf16_t* Bt; int M, N, K; };

struct StaticOrder {
    int nM, nN, nwg, G, c;
    __host__ __device__ void init(int M, int N, int G_, int c_) { nM = M / BM; nN = N / BM; nwg = nM * nN; G = G_; c = c_; }
    __host__ __device__ bool next(int i, Unit& u) const {
        const long L = (long)i * G + c; if (L >= nwg) return false;
        int wgid = (int)L; { const int q = nwg / NXCD, r = nwg % NXCD, xcd = wgid % NXCD, off = wgid / NXCD; wgid = (xcd < r ? xcd * (q + 1) : r * (q + 1) + (xcd - r) * q) + off; }
        const int nig = WGM * nN, gid = wgid / nig, fm = gid * WGM, gsz = (nM - fm) < WGM ? (nM - fm) : WGM;
        u.pm = fm + ((wgid % nig) % gsz); u.pn = (wgid % nig) / gsz; return true;
    }
    __device__ __forceinline__ void a_ready(const Unit&) const {}
    __device__ __forceinline__ void done(const Unit&) const {}
};

__device__ __forceinline__ unsigned cvt_pk_bf16(float lo, float hi) { unsigned r; asm volatile("v_cvt_pk_bf16_f32 %0, %1, %2\n\ts_nop 1" : "=v"(r) : "v"(lo), "v"(hi)); return r; }
__device__ __forceinline__ unsigned bf16_rne_bits(float f) { const unsigned u = __builtin_bit_cast(unsigned, f); return (u + 0x7fffu + ((u >> 16) & 1u)) >> 16; }
__device__ __forceinline__ unsigned cvt_pk_bf16_sw(float lo, float hi) { return bf16_rne_bits(lo) | (bf16_rne_bits(hi) << 16); }
typedef unsigned u32x2 __attribute__((ext_vector_type(2)));
__device__ __forceinline__ float silu_f(float x) { return x * __builtin_amdgcn_rcpf(1.0f + __builtin_amdgcn_exp2f(-1.4426950408889634f * x)); }

struct EpiSwiGLU {
    static constexpr bool PERM = true, AFTER_DRAIN = false;
    bf16_t* O; int ldc;
    __device__ __forceinline__ void operator()(const f32x4 (&acc)[2][2][4][2], const Unit& u, int wr, int wc, int fr, int fq) const {
        const int row0 = u.pm * BM + wr * 64 + fr, col0 = u.pn * 128 + wc * 32 + 8 * fq;
#pragma unroll
        for (int ai = 0; ai < 2; ++ai)
#pragma unroll
            for (int m = 0; m < 4; ++m) { bf16_t* rowp = O + (size_t)(row0 + ai * HALF + m * 16) * ldc + col0;
                const f32x4 g0 = acc[ai][0][m][0], g1 = acc[ai][0][m][1], u0 = acc[ai][1][m][0], u1 = acc[ai][1][m][1];
                u32x4 w;
                w.x = cvt_pk_bf16(silu_f(g0[0]) * u0[0], silu_f(g0[1]) * u0[1]); w.y = cvt_pk_bf16(silu_f(g0[2]) * u0[2], silu_f(g0[3]) * u0[3]);
                w.z = cvt_pk_bf16(silu_f(g1[0]) * u1[0], silu_f(g1[1]) * u1[1]); w.w = cvt_pk_bf16(silu_f(g1[2]) * u1[2], silu_f(g1[3]) * u1[3]);
                *(u32x4*)rowp = w; }
    }
};
struct EpiProj {
    static constexpr bool PERM = true, AFTER_DRAIN = false;
    bf16_t* O; int ldc;
    __device__ __forceinline__ void operator()(const f32x4 (&acc)[2][2][4][2], const Unit& u, int wr, int wc, int fr, int fq) const {
        const int row0 = u.pm * BM + wr * 64 + fr, col0 = u.pn * BM + wc * 32 + 8 * fq;
#pragma unroll
        for (int ai = 0; ai < 2; ++ai)
#pragma unroll
            for (int m = 0; m < 4; ++m) { bf16_t* rowp = O + (size_t)(row0 + ai * HALF + m * 16) * ldc + col0;
#pragma unroll
                for (int bj = 0; bj < 2; ++bj) { const f32x4 v0 = acc[ai][bj][m][0], v1 = acc[ai][bj][m][1]; u32x4 w;
                    w.x = cvt_pk_bf16_sw(v0[0], v0[1]); w.y = cvt_pk_bf16_sw(v0[2], v0[3]); w.z = cvt_pk_bf16_sw(v1[0], v1[1]); w.w = cvt_pk_bf16_sw(v1[2], v1[3]);
                    *(u32x4*)(rowp + bj * HALF) = w; } }
    }
};
struct EpiResid {
    static constexpr bool PERM = false, AFTER_DRAIN = false;
    const float* base_p; const float* base_s; float* out; const float* gate; float gs; int mp;
    __device__ __forceinline__ void operator()(const f32x4 (&acc)[2][2][4][2], const Unit& u, int wr, int wc, int fr, int fq) const {
        const int col0 = u.pn * BM + wc * 32 + 4 * fq;
#pragma unroll
        for (int ai = 0; ai < 2; ++ai)
#pragma unroll
            for (int m = 0; m < 4; ++m) { const int r = u.pm * BM + ai * HALF + wr * 64 + m * 16 + fr;
                const int q = r < mp ? (r >> 11) : 8 + ((r - mp) >> 3);
                const float* bp = (r < mp ? base_p + (size_t)r * 1024 : base_s + (size_t)(r - mp) * 1024) + col0;
                const float* gp = gate + (size_t)q * 9216 + col0; float* op = out + (size_t)r * 1024 + col0;
#pragma unroll
                for (int bj = 0; bj < 2; ++bj)
#pragma unroll
                    for (int n = 0; n < 2; ++n) { const f32x4 b = *(const f32x4*)(bp + bj * HALF + n * 16), g = *(const f32x4*)(gp + bj * HALF + n * 16);
                        *(f32x4*)(op + bj * HALF + n * 16) = b + (acc[ai][bj][m][n] * g) * gs; }
                if (m & 1) asm volatile("" ::: "memory"); }
    }
};
template <class Epi, class Sched, bool ALIGN_EPI = false, bool SP2 = false>
__device__ __forceinline__ void gemm_phase(PG8_LAS unsigned char* lds, const Gemm g, const Sched& S, const Epi& E) {
    int tid_ = threadIdx.x; asm volatile("" : "+v"(tid_));
    const int tid = tid_, wid = __builtin_amdgcn_readfirstlane(tid >> 6), lane = tid & 63, wr = wid >> 2, wc = wid & 3, fr = lane & 15, fq = lane >> 4;
    const int K = g.K, nt = K / BK;
    unsigned voffA[2], voffB[2];
#pragma unroll
    for (int i = 0; i < 2; ++i) { int R, C; stage_rc(tid * 16 + i * 8192, R, C); const int Rb = Epi::PERM ? ((R & ~31) + perm32(R & 31)) : R;
        voffA[i] = (unsigned)(R * K + C) * 2u; voffB[i] = (unsigned)(Rb * K + C) * 2u; }
    const size_t kstep = (size_t)(BK * 2);
    const size_t hstep = (size_t)HALF * K * 2;
    const size_t tstep = 2 * hstep;
    const unsigned ldsw = (unsigned)wid * 1024u;
    const int aoff = lds_byte(wr * 64 + fr, fq * 8), boff = lds_byte(wc * 32 + fr, fq * 8);
#define PG8_SA(b, h) (((b) * 2 + (h)) * HTB)
#define PG8_SB(b, h) ((4 + (b) * 2 + (h)) * HTB)
#define PG8_STAGE(bufoff, gbase, voff) do { _Pragma("unroll") for (int _i = 0; _i < 2; ++_i) \
        __builtin_amdgcn_global_load_lds((const unsigned*)((const char*)(gbase) + (voff)[_i]), (PG8_LAS unsigned*)(lds + (bufoff) + ldsw + _i * 8192), 16, 0, 0); } while (0)
#define PG8_LDA(dst, b, h) do { _Pragma("unroll") for (int m = 0; m < 4; ++m) _Pragma("unroll") for (int k = 0; k < 2; ++k) dst[m][k] = *(const PG8_LAS bf16x8*)(lds + PG8_SA(b, h) + aoff + m * 2048 + k * 1024); } while (0)
#define PG8_LDB(dst, b, h) do { _Pragma("unroll") for (int n = 0; n < 2; ++n) _Pragma("unroll") for (int k = 0; k < 2; ++k) dst[n][k] = *(const PG8_LAS bf16x8*)(lds + PG8_SB(b, h) + boff + n * 2048 + k * 1024); } while (0)
#define PG8_MMA(ai, bj, At, Bt) do { __builtin_amdgcn_s_setprio(1); _Pragma("unroll") for (int m = 0; m < 4; ++m) _Pragma("unroll") for (int n = 0; n < 2; ++n) _Pragma("unroll") for (int k = 0; k < 2; ++k) \
        acc[ai][bj][m][n] = __builtin_amdgcn_mfma_f32_16x16x32_bf16(Bt[n][k], At[m][k], acc[ai][bj][m][n], 0, 0, 0); __builtin_amdgcn_s_setprio(0); } while (0)
#define PG8_WAIT_V(n) asm volatile("s_waitcnt vmcnt(" #n ")" ::: "memory")
#define PG8_WAIT_L(n) asm volatile("s_waitcnt lgkmcnt(" #n ")" ::: "memory")
#define PG8_BAR __builtin_amdgcn_s_barrier()
#define PG8_SCHED __builtin_amdgcn_sched_barrier(0)
    Unit cur, nxt; int ui = 0;
    if (!S.next(0, cur)) return;
    f32x4 acc[2][2][4][2];
#pragma unroll
    for (int a = 0; a < 2; ++a)
#pragma unroll
        for (int b = 0; b < 2; ++b)
#pragma unroll
            for (int m = 0; m < 4; ++m)
#pragma unroll
                for (int n = 0; n < 2; ++n) acc[a][b][m][n] = (f32x4){0.f, 0.f, 0.f, 0.f};
    bf16x8 At[4][2], B0[2][2], B1[2][2];
    const char* cA = (const char*)g.A + (size_t)cur.pm * tstep; const char* cB = (const char*)g.Bt + (size_t)cur.pn * tstep;
    S.a_ready(cur);
    if constexpr (SP2) {
        PG8_STAGE(PG8_SB(0, 0), cB, voffB); PG8_STAGE(PG8_SB(0, 1), cB + hstep, voffB); PG8_STAGE(PG8_SA(0, 0), cA, voffA); PG8_STAGE(PG8_SA(0, 1), cA + hstep, voffA);
        if (wr == 1) PG8_BAR;
        PG8_WAIT_V(2); PG8_BAR;
        PG8_STAGE(PG8_SB(1, 0), cB + kstep, voffB); PG8_STAGE(PG8_SA(1, 0), cA + kstep, voffA); PG8_STAGE(PG8_SB(1, 1), cB + hstep + kstep, voffB);
        PG8_WAIT_V(6); PG8_BAR;
    } else {
        PG8_STAGE(PG8_SB(0, 0), cB, voffB); PG8_STAGE(PG8_SA(0, 0), cA, voffA); PG8_STAGE(PG8_SB(0, 1), cB + hstep, voffB); PG8_STAGE(PG8_SA(0, 1), cA + hstep, voffA);
        if (wr == 1) PG8_BAR;
        PG8_WAIT_V(4); PG8_BAR;
        PG8_STAGE(PG8_SB(1, 0), cB + kstep, voffB); PG8_STAGE(PG8_SA(1, 0), cA + kstep, voffA); PG8_STAGE(PG8_SB(1, 1), cB + hstep + kstep, voffB);
        PG8_WAIT_V(6); PG8_BAR;
    }
    for (;;) {
        const bool has_next = S.next(ui + 1, nxt);
        const char* nA = has_next ? (const char*)g.A + (size_t)nxt.pm * tstep : cA; const char* nB = has_next ? (const char*)g.Bt + (size_t)nxt.pn * tstep : cB;
        for (int t = 0; t < nt; t += 2) {
            const bool last = (t == nt - 2);
            const char* a1 = cA + (size_t)(t + 1) * kstep;
            const char* a2 = last ? nA : cA + (size_t)(t + 2) * kstep; const char* b2 = last ? nB : cB + (size_t)(t + 2) * kstep;
            const char* a3 = a2 + kstep; const char* b3 = b2 + kstep;
            if (last && has_next) S.a_ready(nxt);
            if constexpr (SP2) {
            PG8_LDB(B0, 0, 0); PG8_LDB(B1, 0, 1); PG8_SCHED; PG8_LDA(At, 0, 0); PG8_STAGE(PG8_SA(1, 1), a1 + hstep, voffA);
            PG8_WAIT_V(8); PG8_WAIT_L(0); PG8_BAR; PG8_MMA(0, 0, At, B0); PG8_MMA(0, 1, At, B1); PG8_BAR; PG8_SCHED;
            PG8_LDA(At, 0, 1); PG8_STAGE(PG8_SB(0, 0), b2, voffB); PG8_STAGE(PG8_SB(0, 1), b2 + hstep, voffB); PG8_STAGE(PG8_SA(0, 0), a2, voffA);
            PG8_WAIT_V(8); PG8_WAIT_L(0); PG8_BAR; PG8_MMA(1, 0, At, B0); PG8_MMA(1, 1, At, B1); PG8_BAR; PG8_SCHED;
            PG8_LDB(B0, 1, 0); PG8_LDB(B1, 1, 1); PG8_SCHED; PG8_LDA(At, 1, 0); PG8_STAGE(PG8_SA(0, 1), a2 + hstep, voffA);
            PG8_WAIT_V(8); PG8_WAIT_L(0); PG8_BAR; PG8_MMA(0, 0, At, B0); PG8_MMA(0, 1, At, B1); PG8_BAR; PG8_SCHED;
            PG8_LDA(At, 1, 1); PG8_STAGE(PG8_SB(1, 0), b3, voffB); PG8_STAGE(PG8_SB(1, 1), b3 + hstep, voffB); PG8_STAGE(PG8_SA(1, 0), a3, voffA);
            PG8_WAIT_V(8); PG8_WAIT_L(0); PG8_BAR; PG8_MMA(1, 0, At, B0); PG8_MMA(1, 1, At, B1); PG8_BAR; PG8_SCHED;
            } else {
            PG8_LDB(B0, 0, 0); PG8_SCHED; PG8_LDA(At, 0, 0); PG8_STAGE(PG8_SA(1, 1), a1 + hstep, voffA);
            PG8_WAIT_L(8); PG8_BAR; PG8_WAIT_L(0); PG8_MMA(0, 0, At, B0); PG8_BAR; PG8_SCHED;
            PG8_LDB(B1, 0, 1); PG8_STAGE(PG8_SB(0, 0), b2, voffB);
            PG8_BAR; PG8_WAIT_L(0); PG8_MMA(0, 1, At, B1); PG8_BAR;
            PG8_LDA(At, 0, 1); PG8_STAGE(PG8_SA(0, 0), a2, voffA);
            PG8_BAR; PG8_WAIT_L(0); PG8_MMA(1, 0, At, B0); PG8_BAR; PG8_SCHED;
            PG8_STAGE(PG8_SB(0, 1), b2 + hstep, voffB);
            PG8_WAIT_V(6); PG8_BAR; PG8_MMA(1, 1, At, B1); PG8_BAR;
            PG8_LDB(B0, 1, 0); PG8_SCHED; PG8_LDA(At, 1, 0); PG8_STAGE(PG8_SA(0, 1), a2 + hstep, voffA);
            PG8_WAIT_L(8); PG8_BAR; PG8_WAIT_L(0); PG8_MMA(0, 0, At, B0); PG8_BAR; PG8_SCHED;
            PG8_LDB(B1, 1, 1); PG8_STAGE(PG8_SB(1, 0), b3, voffB);
            PG8_BAR; PG8_WAIT_L(0); PG8_MMA(0, 1, At, B1); PG8_BAR;
            PG8_LDA(At, 1, 1); PG8_STAGE(PG8_SA(1, 0), a3, voffA);
            PG8_BAR; PG8_WAIT_L(0); PG8_MMA(1, 0, At, B0); PG8_BAR; PG8_SCHED;
            PG8_STAGE(PG8_SB(1, 1), b3 + hstep, voffB);
            PG8_WAIT_V(6); PG8_BAR; PG8_MMA(1, 1, At, B1); PG8_BAR;
            }
        }
        if constexpr (ALIGN_EPI) { if (wr == 0) PG8_BAR; }
        if constexpr (!Epi::AFTER_DRAIN) { E(acc, cur, wr, wc, fr, fq); S.done(cur); }
        if (!has_next) break;
#pragma unroll
        for (int a = 0; a < 2; ++a)
#pragma unroll
            for (int b = 0; b < 2; ++b)
#pragma unroll
                for (int m = 0; m < 4; ++m)
#pragma unroll
                    for (int n = 0; n < 2; ++n) acc[a][b][m][n] = (f32x4){0.f, 0.f, 0.f, 0.f};
        cur = nxt; cA = nA; cB = nB; ++ui;
        if constexpr (ALIGN_EPI) { if (wr == 1) PG8_BAR; }
    }
    PG8_WAIT_V(0);
    if constexpr (!ALIGN_EPI) { if (wr == 0) PG8_BAR; }
    PG8_BAR;
    if constexpr (Epi::AFTER_DRAIN) { E.fused(acc, cur, wr, wc, fr, fq, lds, wid, lane); S.done(cur); }
#undef PG8_SA
#undef PG8_SB
#undef PG8_STAGE
#undef PG8_LDA
#undef PG8_LDB
#undef PG8_MMA
#undef PG8_WAIT_V
#undef PG8_WAIT_L
#undef PG8_BAR
#undef PG8_SCHED
}
}

constexpr int NWAVES = 8;
constexpr int MP = 16384, MS = 1024, M = MP + MS, D = 1024, FF = 2816, NUP = 2 * FF, NIN = 2304, NSEQ = 136, NADA = 9216;
constexpr int DIN = 2064;
constexpr int PJ_U = 0, PJ_Q = 512, PJ_K = 768, PJ_V = 1024, PJ_OG = 1536, PJ_GLR = 2048;
constexpr float EPS = 1e-6f;
constexpr size_t OUT_X = 0, OUT_POOLP = (size_t)M * D, OUT_GLAP = OUT_POOLP + 8 * 15 * 512, OUT_POOLS = OUT_GLAP + 8 * 4 * 64 * 128, OUT_GLAS = OUT_POOLS + 128 * 15 * 512, OUT_END = OUT_GLAS + (size_t)128 * 4 * 64 * 128;
constexpr size_t KiB = 1024, MiB = 1u << 20;
constexpr size_t WS_CTL = 0, CTL_ZERO_BYTES = 1 * MiB;
constexpr size_t WS_W1U = 1 * MiB, WS_W1D = 12 * MiB, WS_WIN = WS_W1D + 5632 * KiB, WS_WOUT = 22 * MiB, WS_W2U = 24 * MiB, WS_W2D = 35 * MiB, WS_WPT = WS_W2D + 5632 * KiB;
constexpr size_t WS_DEC = WS_WPT + 256 * KiB, WS_ADA = 41 * MiB, WS_H = 46 * MiB, WS_ZO = 80 * MiB, WS_UPD = 114 * MiB, WS_ACT = 130 * MiB, WS_PROJ = WS_ACT, WS_SPREV = 224 * MiB, WS_END = 240 * MiB;
static_assert(WS_W1U + (size_t)NUP * D * 2 <= WS_W1D && WS_W1D + (size_t)D * FF * 2 <= WS_WIN && WS_WIN + (size_t)NIN * D * 2 <= WS_WOUT && WS_WOUT + (size_t)D * D * 2 <= WS_W2U && WS_W2U + (size_t)NUP * D * 2 <= WS_W2D &&
              WS_W2D + (size_t)D * FF * 2 <= WS_WPT && WS_WPT + 4 * 128 * 128 * 2 <= WS_DEC && WS_DEC + 1024 * 64 * 4 <= WS_ADA && WS_ADA + (size_t)NSEQ * NADA * 4 <= WS_H && WS_H + (size_t)M * D * 2 <= WS_ZO &&
              WS_ZO + (size_t)M * D * 2 <= WS_UPD && WS_UPD + (size_t)1024 * 8192 * 2 <= WS_ACT && WS_ACT + (size_t)M * FF * 2 <= WS_SPREV && WS_SPREV + (size_t)1024 * 8192 * 2 <= WS_END && WS_PROJ + (size_t)M * NIN * 2 <= WS_END, "d_ws map");
constexpr int CW_BAR = 4096;
constexpr int CW_DG = 24576;
constexpr int CW_Q = 16384;
constexpr int RING_BYTES = 131072, LDSCTL_OFF = RING_BYTES, MISC_OFF = LDSCTL_OFF + 320, LDS_BYTES = 147456;

#define GAS __attribute__((address_space(1)))
#define LAS __attribute__((address_space(3)))
typedef unsigned short bf16;
typedef unsigned v4u __attribute__((ext_vector_type(4)));
typedef unsigned v2u __attribute__((ext_vector_type(2)));
typedef float f32x4 __attribute__((ext_vector_type(4)));
typedef short bf16x8 __attribute__((ext_vector_type(8)));
typedef short s16x4 __attribute__((ext_vector_type(4)));
typedef GAS unsigned gu32;
#define RLX_AGENT __ATOMIC_RELAXED, __HIP_MEMORY_SCOPE_AGENT
#define LDS_WAIT() asm volatile("s_waitcnt lgkmcnt(0)" ::: "memory")
__device__ __forceinline__ unsigned pk2(float lo, float hi) { return pg8::cvt_pk_bf16(lo, hi); }
__device__ __forceinline__ float bflo(unsigned w) { return __uint_as_float(w << 16); }
__device__ __forceinline__ float bfhi(unsigned w) { return __uint_as_float(w & 0xffff0000u); }
__device__ __forceinline__ float silu_f(float x) { return pg8::silu_f(x); }
__device__ __forceinline__ int seq_of(int r) { return r < MP ? (r >> 11) : 8 + ((r - MP) >> 3); }

#define XB_TMO      128
#define XB_XCNT(j)  (256  + 64 * (j))
#define XB_XSUB(j)  (1280 + 64 * (j))
#define XB_XGEN(j)  (2304 + 64 * (j))
#define XB_TOP      3328
#define XB_TOPGEN   3392
#define XCD_BAR_WORDS 3456
#define XB_SPIN_CAP (1u << 18)

__device__ __forceinline__ unsigned xb_ld(unsigned* p)              { return __hip_atomic_load(p, __ATOMIC_RELAXED, __HIP_MEMORY_SCOPE_AGENT); }
__device__ __forceinline__ unsigned xb_add(unsigned* p, unsigned v) { return __hip_atomic_fetch_add(p, v, __ATOMIC_RELAXED, __HIP_MEMORY_SCOPE_AGENT); }
__device__ __forceinline__ unsigned xb_xcc_id() { return (unsigned)__builtin_amdgcn_s_getreg((3 << 11) | 20) & 0xFu; }
#define XB_SPIN(cond, bar) do { unsigned _sp = 0; while (cond) { __builtin_amdgcn_s_sleep(1); \
    if ((++_sp & 255u) == 0u) { if (xb_ld(&(bar)[XB_TMO])) break; if (_sp > XB_SPIN_CAP) { atomicAdd(&(bar)[XB_TMO], 1u); break; } } } } while (0)

struct XcdBarrier {
    unsigned* bar; unsigned x;
    volatile LAS unsigned* st;
};

__device__ __forceinline__ XcdBarrier xcd_barrier_post(unsigned* bar, volatile LAS unsigned* st) {
    XcdBarrier b; b.bar = bar; b.x = xb_xcc_id(); b.st = st;
    if (threadIdx.x == 0) (void)xb_add(&bar[XB_XCNT(b.x)], 1u);
    return b;
}
__device__ __forceinline__ void xcd_barrier_complete(unsigned* bar, unsigned x, unsigned& nloc, unsigned& nx) {
    const unsigned G = gridDim.x * gridDim.y * gridDim.z;
    unsigned sum, cnt, mine, sp = 0u;
    for (;;) {
        sum = 0u; cnt = 0u; mine = 0u;
#pragma unroll
        for (unsigned j = 0; j < 16; ++j) { const unsigned c = xb_ld(&bar[XB_XCNT(j)]); sum += c; cnt += (c > 0u) ? 1u : 0u; mine = (j == x) ? c : mine; }
        if (sum == G) break;
        __builtin_amdgcn_s_sleep(1);
        if ((++sp & 255u) == 0u) { if (xb_ld(&bar[XB_TMO])) break; if (sp > XB_SPIN_CAP) { atomicAdd(&bar[XB_TMO], 1u); break; } }
    }
    nloc = mine > 0u ? mine : 1u; nx = cnt > 0u ? cnt : 1u;
}

__device__ __forceinline__ void xcd_barrier(const XcdBarrier& b) {
    asm volatile("s_waitcnt vmcnt(0)" ::: "memory");
    __syncthreads();
    if (threadIdx.x == 0) {
        unsigned* bar = b.bar;
        __builtin_amdgcn_s_waitcnt(0);
        unsigned nloc = b.st[0], nx = b.st[1];
        if (nloc == 0u) { xcd_barrier_complete(bar, b.x, nloc, nx); b.st[0] = nloc; b.st[1] = nx; }
        const unsigned old = xb_add(&bar[XB_XSUB(b.x)], 1u);
        const unsigned gen = old / nloc;
        if (old + 1u == (gen + 1u) * nloc) {
            __builtin_amdgcn_fence(__ATOMIC_RELEASE, "agent");
            asm volatile("s_waitcnt vmcnt(0)" ::: "memory");
            const unsigned og = xb_add(&bar[XB_TOP], 1u);
            const unsigned tg = og / nx;
            if (og + 1u == (tg + 1u) * nx) xb_add(&bar[XB_TOPGEN], 1u);
            else XB_SPIN(xb_ld(&bar[XB_TOPGEN]) == tg, bar);
            __builtin_amdgcn_fence(__ATOMIC_ACQUIRE, "agent");
            xb_add(&bar[XB_XGEN(b.x)], 1u);
            asm volatile("s_waitcnt vmcnt(0)" ::: "memory");
        } else {
            XB_SPIN(xb_ld(&bar[XB_XGEN(b.x)]) == gen, bar);
            __builtin_amdgcn_fence(__ATOMIC_ACQUIRE, "agent");
            asm volatile("s_waitcnt vmcnt(0)" ::: "memory");
        }
    }
    __syncthreads();
}


struct Frame {
    LAS unsigned char* lds;
    volatile LAS unsigned* MISC;
    gu32* ctl;
    int G;
};
__device__ __forceinline__ int otid() { int t = threadIdx.x; asm volatile("" : "+v"(t)); return t; }
typedef const float* fptr_t; typedef float* fptrw_t; typedef unsigned char* bptr_t;
__device__ __forceinline__ const __attribute__((address_space(4))) unsigned char* kargs() { const __attribute__((address_space(4))) unsigned char* p = (const __attribute__((address_space(4))) unsigned char*)__builtin_amdgcn_kernarg_segment_ptr(); asm volatile("" : "+s"(p)); return p; }
#define KIN(i) (((const __attribute__((address_space(4))) fptr_t*)kargs())[i])
#define KOUT (((const __attribute__((address_space(4))) fptrw_t*)kargs())[23])
#define KWS (((const __attribute__((address_space(4))) bptr_t*)kargs())[24])
__device__ __forceinline__ float wave_sum(float v) {
#pragma unroll
    for (int o = 1; o < 64; o <<= 1) v += __shfl_xor(v, o);
    return v;
}
__device__ __forceinline__ int wave_dequeue(gu32* head, int lane) {
    unsigned v = 0; if (lane == 0) v = __hip_atomic_fetch_add(head, 1u, RLX_AGENT);
    return (int)__builtin_amdgcn_readfirstlane(v);
}
__device__ __forceinline__ int block_dequeue(Frame& F, gu32* head) {
    if (threadIdx.x == 0) F.MISC[0] = __hip_atomic_fetch_add(head, 1u, RLX_AGENT);
    __syncthreads(); const int v = (int)F.MISC[0]; __syncthreads(); return v;
}

__device__ __forceinline__ void transpose_item(const float* W, int ldw, int csrc, int nvalid, int K, bf16* WT, int drow, int k0, LAS float* scr, int lane) {
    const int n = lane & 31;
#pragma unroll 8
    for (int i = 0; i < 32; ++i) { const int kk = 2 * i + (lane >> 5); float v = 0.f; if (n < nvalid) v = W[(size_t)(k0 + kk) * ldw + csrc + n]; scr[kk * 33 + n] = v; }
    LDS_WAIT(); asm volatile("" ::: "memory");
    const int c = lane & 7;
#pragma unroll
    for (int j = 0; j < 4; ++j) { const int nn = (lane >> 3) + 8 * j; const LAS float* s = scr + (8 * c) * 33 + nn;
        v4u o; o.x = pk2(s[0 * 33], s[1 * 33]); o.y = pk2(s[2 * 33], s[3 * 33]); o.z = pk2(s[4 * 33], s[5 * 33]); o.w = pk2(s[6 * 33], s[7 * 33]);
        *(GAS v4u*)(WT + (size_t)(drow + nn) * K + k0 + 8 * c) = o; }
    LDS_WAIT(); asm volatile("" ::: "memory");
}
constexpr int I_UP = 16 * 176, I_DN = 44 * 32, I_IN = 16 * 72, I_OUT = 16 * 32, I_POOL = 4 * 8;
constexpr int CV_1U = 0, CV_1D = CV_1U + I_UP, CV_IN = CV_1D + I_DN, CV_OUT = CV_IN + I_IN, CV_2U = CV_OUT + I_OUT, CV_2D = CV_2U + I_UP, CV_POOL = CV_2D + I_DN, CV_END = CV_POOL + I_POOL;
__device__ __forceinline__ void up_item(const float* W, bf16* WT, int r, LAS float* scr, int lane) {
    const int kb = r / 176, nb = r % 176, n0 = 32 * nb; const int j0 = n0 < FF ? n0 : n0 - FF;
    const int drow = 256 * (j0 >> 7) + (j0 & 127) + (n0 < FF ? 0 : 128);
    transpose_item(W, NUP, n0, 32, D, WT, drow, 64 * kb, scr, lane);
}
__device__ __forceinline__ void convert_item(Frame& F, int it, LAS float* scr) {
    unsigned char* ws = KWS; const int lane = otid() & 63;
    if (it < CV_1D) { up_item(KIN(11), (bf16*)(ws + WS_W1U), it - CV_1U, scr, lane); return; }
    if (it < CV_IN) { const int r = it - CV_1D; transpose_item(KIN(12), D, 32 * (r % 32), 32, FF, (bf16*)(ws + WS_W1D), 32 * (r % 32), 64 * (r / 32), scr, lane); return; }
    if (it < CV_OUT) { const int r = it - CV_IN, kb = r / 72, nb = r % 72; int csrc, drow, nv;
        if (nb < 48) { csrc = 32 * nb; drow = 32 * nb; nv = 32; } else if (nb < 64) { csrc = 1552 + 32 * (nb - 48); drow = PJ_OG + 32 * (nb - 48); nv = 32; } else { csrc = 1536; drow = PJ_GLR + 32 * (nb - 64); nv = nb == 64 ? 16 : 0; }
        transpose_item(KIN(13), DIN, csrc, nv, D, (bf16*)(ws + WS_WIN), drow, 64 * kb, scr, lane); return; }
    if (it < CV_2U) { const int r = it - CV_OUT; transpose_item(KIN(19), D, 32 * (r % 32), 32, D, (bf16*)(ws + WS_WOUT), 32 * (r % 32), 64 * (r / 32), scr, lane); return; }
    if (it < CV_2D) { up_item(KIN(20), (bf16*)(ws + WS_W2U), it - CV_2U, scr, lane); return; }
    if (it < CV_POOL) { const int r = it - CV_2D; transpose_item(KIN(21), D, 32 * (r % 32), 32, FF, (bf16*)(ws + WS_W2D), 32 * (r % 32), 64 * (r / 32), scr, lane); return; }
    { const int r = it - CV_POOL, g = r >> 3, kb = (r >> 2) & 1, nb = r & 3;
      transpose_item(KIN(16) + g * 16384, 128, 32 * nb, 32, 128, (bf16*)(ws + WS_WPT) + g * 16384, 32 * nb, 64 * kb, scr, lane); }
}

__device__ __forceinline__ void ada_unit(Frame& F, int unit) {
    const int tid = otid(), lane = tid & 63, w = __builtin_amdgcn_readfirstlane(tid >> 6), mh = w >> 2, ks = w & 3, fr = lane & 15, fq = lane >> 4, n0 = unit * 64;
    const int mt0 = mh ? 5 : 0, nmt = mh ? 4 : 5;
    const float* W = KIN(9); const float* cp = KIN(4); const float* cs = KIN(5);
    f32x4 acc[5][4];
#pragma unroll
    for (int i = 0; i < 5; ++i)
#pragma unroll
        for (int t = 0; t < 4; ++t) acc[i][t] = (f32x4){0.f, 0.f, 0.f, 0.f};
    for (int kk = 0; kk < 8; ++kk) {
        const int k0 = ks * 256 + kk * 32 + 8 * fq;
        bf16x8 b[4];
#pragma unroll
        for (int j = 0; j < 8; j += 2) { const f32x4 w0 = *(const f32x4*)(W + (size_t)(k0 + j) * NADA + n0 + 4 * fr), w1 = *(const f32x4*)(W + (size_t)(k0 + j + 1) * NADA + n0 + 4 * fr);
#pragma unroll
            for (int t = 0; t < 4; ++t) { const unsigned p = pk2(w0[t], w1[t]); b[t][j] = (short)(p & 0xffffu); b[t][j + 1] = (short)(p >> 16); } }
#pragma unroll
        for (int i = 0; i < 5; ++i) if (i < nmt) {
            int s = 16 * (mt0 + i) + fr; s = s > NSEQ - 1 ? NSEQ - 1 : s;
            const float* crow = (s < 8 ? cp + (size_t)s * D : cs + (size_t)(s - 8) * D) + k0;
            const f32x4 c0 = *(const f32x4*)crow, c1 = *(const f32x4*)(crow + 4);
            union { bf16x8 v; unsigned u[4]; } a;
            a.u[0] = pk2(silu_f(c0[0]), silu_f(c0[1])); a.u[1] = pk2(silu_f(c0[2]), silu_f(c0[3])); a.u[2] = pk2(silu_f(c1[0]), silu_f(c1[1])); a.u[3] = pk2(silu_f(c1[2]), silu_f(c1[3]));
#pragma unroll
            for (int t = 0; t < 4; ++t) acc[i][t] = __builtin_amdgcn_mfma_f32_16x16x32_bf16(a.v, b[t], acc[i][t], 0, 0, 0);
        }
    }
    LAS float* red = (LAS float*)F.lds;
    if (ks > 0) { const int base = (mh * 3 + ks - 1) * 80;
#pragma unroll
        for (int i = 0; i < 5; ++i)
#pragma unroll
            for (int t = 0; t < 4; ++t)
#pragma unroll
                for (int r = 0; r < 4; ++r) red[(base + (i * 4 + t) * 4 + r) * 64 + lane] = acc[i][t][r]; }
    __syncthreads();
    if (ks == 0) {
        const f32x4 bias = *(const f32x4*)(KIN(10) + n0 + 4 * fr);
        float* ADA = (float*)(KWS + WS_ADA);
#pragma unroll
        for (int i = 0; i < 5; ++i) if (i < nmt) {
#pragma unroll
            for (int t = 0; t < 4; ++t) {
#pragma unroll
                for (int r = 0; r < 4; ++r) { float v = acc[i][t][r];
#pragma unroll
                    for (int p = 0; p < 3; ++p) v += red[((mh * 3 + p) * 80 + (i * 4 + t) * 4 + r) * 64 + lane];
                    const int row = 16 * (mt0 + i) + 4 * fq + r;
                    if (row < NSEQ) ADA[(size_t)row * NADA + n0 + 4 * fr + t] = v + bias[t]; } } }
    }
    __syncthreads();
}

template <bool FINAL>
__device__ __forceinline__ void norm_group(Frame& F, const float* xp, const float* xs, const float* ln, int shift_chunk, bf16* Hout, float* Yout, int grp) {
    const int lane = otid() & 63, r0 = grp * 8, q = seq_of(r0);
    const float* ADA = (const float*)(KWS + WS_ADA) + (size_t)q * NADA + shift_chunk * D;
    f32x4 g[4], s[4];
#pragma unroll
    for (int j = 0; j < 4; ++j) { const int k = 4 * lane + 256 * j; g[j] = *(const f32x4*)(ln + k);
        if (!FINAL) { g[j] = g[j] * (*(const f32x4*)(ADA + D + k) + 1.0f); s[j] = *(const f32x4*)(ADA + k); } else s[j] = (f32x4){0.f, 0.f, 0.f, 0.f}; }
#pragma unroll
    for (int hb = 0; hb < 2; ++hb) {
        f32x4 v[4][4]; float ss[4];
#pragma unroll
        for (int rr = 0; rr < 4; ++rr) { const int row = r0 + hb * 4 + rr; const float* xr = (row < MP ? xp + (size_t)row * D : xs + (size_t)(row - MP) * D) + 4 * lane; float a = 0.f;
#pragma unroll
            for (int j = 0; j < 4; ++j) { v[rr][j] = *(const f32x4*)(xr + 256 * j); a += (v[rr][j].x * v[rr][j].x + v[rr][j].y * v[rr][j].y) + (v[rr][j].z * v[rr][j].z + v[rr][j].w * v[rr][j].w); }
            ss[rr] = a; }
#pragma unroll
        for (int rr = 0; rr < 4; ++rr) { const int row = r0 + hb * 4 + rr; const float rstd = 1.0f / sqrtf(wave_sum(ss[rr]) * (1.0f / D) + EPS);
#pragma unroll
            for (int j = 0; j < 4; ++j) { const f32x4 o = v[rr][j] * rstd * g[j] + s[j];
                if (FINAL) *(f32x4*)(Yout + (size_t)row * D + 4 * lane + 256 * j) = o;
                else { v2u w; w.x = pk2(o.x, o.y); w.y = pk2(o.z, o.w); *(GAS v2u*)(Hout + (size_t)row * D + 4 * lane + 256 * j) = w; } } }
    }
}

template <int PITCH>
__device__ __forceinline__ bf16x8 tr8(unsigned img, int row0, int col0, int lane) {
    const unsigned addr = img + (unsigned)((row0 + 8 * (lane >> 4) + ((lane & 15) >> 2)) * PITCH + (col0 + 4 * (lane & 3)) * 2);
    s16x4 lo, hi;
    asm volatile("ds_read_b64_tr_b16 %0, %2\n\tds_read_b64_tr_b16 %1, %2 offset:%3\n\ts_waitcnt lgkmcnt(0)" : "=&v"(lo), "=&v"(hi) : "v"(addr), "i"(4 * PITCH) : "memory");
    return (bf16x8){lo[0], lo[1], lo[2], lo[3], hi[0], hi[1], hi[2], hi[3]};
}

constexpr int G_QIN = 0, G_KIN = 9216, G_KDEC = 18432, G_ATT = 27648, G_VIM = 36864, G_SPV = 54272, G_OST = 71680, G_DEC = 105472, G_END = 105728;
template <int MODE>
__device__ __forceinline__ void gla_item(Frame& F, int item) {
    constexpr int CV = MODE == 2 ? 8 : 64, MT = MODE == 2 ? 1 : 4, KS = MODE == 2 ? 1 : 2;
    const int tid = otid(), lane = tid & 63, w = __builtin_amdgcn_readfirstlane(tid >> 6), fr = lane & 15, fq = lane >> 4;
    int q, h, r0, slot;
    if (MODE == 2) { q = item >> 2; h = item & 3; r0 = MP + 8 * q; slot = 0; }
    else { h = item & 3; const int n = (item >> 2) & 31; q = item >> 7; r0 = q * 2048 + n * 64; slot = (q * 4 + h) * 32 + n; }
    LAS unsigned char* L = F.lds; const unsigned Lb = (unsigned)(size_t)L;
    const bf16* PROJ = (const bf16*)(KWS + WS_PROJ);
    {
        const bool valid = lane < CV; const bf16* prow = PROJ + (size_t)(r0 + (valid ? lane : 0)) * NIN;
        float glr[16];
        { const v4u g0 = *(const v4u*)(prow + PJ_GLR), g1 = *(const v4u*)(prow + PJ_GLR + 8);
#pragma unroll
          for (int i = 0; i < 4; ++i) { glr[2 * i] = bflo(g0[i]); glr[2 * i + 1] = bfhi(g0[i]); glr[8 + 2 * i] = bflo(g1[i]); glr[9 + 2 * i] = bfhi(g1[i]); } }
        const float* w2 = KIN(14) + h * 64 + 8 * w; const float* b2 = KIN(15) + h * 64 + 8 * w;
        float la[8];
#pragma unroll
        for (int j = 0; j < 8; ++j) { float g = b2[j];
#pragma unroll
            for (int r = 0; r < 16; ++r) g += glr[r] * w2[r * 256 + j];
            const float ls = fminf(g, 0.f) - __logf(1.0f + __expf(-fabsf(g)));
            la[j] = valid ? ls * (1.0f / 16.0f) : 0.f; }
#pragma unroll
        for (int off = 1; off < 64; off <<= 1)
#pragma unroll
            for (int j = 0; j < 8; ++j) { const float t = __shfl_up(la[j], off); if (lane >= off) la[j] += t; }
        float bl[8];
#pragma unroll
        for (int j = 0; j < 8; ++j) bl[j] = __shfl(la[j], CV - 1);
        v4u q8 = (v4u){0u, 0u, 0u, 0u}, k8 = (v4u){0u, 0u, 0u, 0u};
        if (valid) { if (MODE != 0) q8 = *(const v4u*)(prow + PJ_Q + h * 64 + 8 * w); k8 = *(const v4u*)(prow + PJ_K + h * 64 + 8 * w); }
        v4u oq, ok, od;
#pragma unroll
        for (int i = 0; i < 4; ++i) { const float e0 = __expf(la[2 * i]), e1 = __expf(la[2 * i + 1]), n0 = __expf(-la[2 * i]), n1 = __expf(-la[2 * i + 1]);
            const float d0 = __expf(bl[2 * i] - la[2 * i]), d1 = __expf(bl[2 * i + 1] - la[2 * i + 1]);
            oq[i] = pk2(bflo(q8[i]) * e0 * 0.125f, bfhi(q8[i]) * e1 * 0.125f); ok[i] = pk2(bflo(k8[i]) * n0, bfhi(k8[i]) * n1); od[i] = pk2(bflo(k8[i]) * d0, bfhi(k8[i]) * d1); }
        if (MODE != 0) { *(LAS v4u*)(L + G_QIN + lane * 144 + 16 * w) = oq; *(LAS v4u*)(L + G_KIN + lane * 144 + 16 * w) = ok; }
        if (MODE != 1) *(LAS v4u*)(L + G_KDEC + lane * 144 + 16 * w) = od;
        if (MODE == 0 && lane < 8) { float v = bl[0];
#pragma unroll
            for (int j = 1; j < 8; ++j) v = lane == j ? bl[j] : v;
            ((float*)(KWS + WS_DEC))[slot * 64 + 8 * w + lane] = __expf(v); }
        if (MODE == 2 && lane < 8) { float v = bl[0];
#pragma unroll
            for (int j = 1; j < 8; ++j) v = lane == j ? bl[j] : v;
            ((LAS float*)(L + G_DEC))[8 * w + lane] = __expf(v); }
    }
#pragma unroll
    for (int i = 0; i < 2; ++i) { const int id = tid + 512 * i, s = id >> 4, ch = id & 15; v4u v = (v4u){0u, 0u, 0u, 0u};
        if (s < CV) v = *(const v4u*)(PROJ + (size_t)(r0 + s) * NIN + PJ_V + h * 128 + 8 * ch);
        *(LAS v4u*)(L + G_VIM + s * 272 + 16 * ch) = v; }
    if (MODE == 1) { const bf16* SP = (const bf16*)(KWS + WS_SPREV) + (size_t)slot * 8192;
#pragma unroll
        for (int i = 0; i < 2; ++i) { const int id = tid + 512 * i, d = id >> 4, ch = id & 15; *(LAS v4u*)(L + G_SPV + d * 272 + 16 * ch) = *(const v4u*)(SP + d * 128 + 8 * ch); } }
    if (MODE == 2) { const float* S0 = KIN(3) + (size_t)item * 8192;
#pragma unroll
        for (int i = 0; i < 2; ++i) { const int id = tid + 512 * i, d = id >> 4, ch = id & 15; const f32x4 a = *(const f32x4*)(S0 + d * 128 + 8 * ch), b = *(const f32x4*)(S0 + d * 128 + 8 * ch + 4);
            v4u v; v.x = pk2(a.x, a.y); v.y = pk2(a.z, a.w); v.z = pk2(b.x, b.y); v.w = pk2(b.z, b.w); *(LAS v4u*)(L + G_SPV + d * 272 + 16 * ch) = v; } }
    __syncthreads();
#if DIAG
    if (MODE == 0) { unsigned bad_ = 0;
        for (int i = 0; i < 2; ++i) { const int id = tid + 512 * i, s_ = id >> 4, ch = id & 15; const v4u a_ = *(const LAS v4u*)(L + G_VIM + s_ * 272 + 16 * ch);
            const v4u b_ = __builtin_nontemporal_load((const v4u*)(PROJ + (size_t)(r0 + s_) * NIN + PJ_V + h * 128 + 8 * ch));
            bad_ += (a_.x != b_.x) + (a_.y != b_.y) + (a_.z != b_.z) + (a_.w != b_.w); }
        if (bad_) { __hip_atomic_fetch_max(F.ctl + CW_DG, (unsigned)(64 - 9), RLX_AGENT); __hip_atomic_fetch_add(F.ctl + CW_DG + 64 * (1 + 9), bad_, RLX_AGENT); } }
    if (MODE == 0 && slot < 64) { bf16* DK = (bf16*)(KWS + 241 * MiB) + (size_t)slot * 12288;
        for (int id = tid; id < 64 * 8; id += 512) { const int r_ = id >> 3, c_ = id & 7; *(GAS v4u*)(DK + r_ * 64 + 8 * c_) = *(const LAS v4u*)(L + G_KDEC + r_ * 144 + 16 * c_); }
        for (int id = tid; id < 64 * 16; id += 512) { const int r_ = id >> 4, c_ = id & 15; *(GAS v4u*)(DK + 4096 + r_ * 128 + 8 * c_) = *(const LAS v4u*)(L + G_VIM + r_ * 272 + 16 * c_); } }
#endif
    if (MODE != 0) {
        if ((w >> 1) < MT && (MODE == 1 || (w & 1) == 0)) { const int mt = w >> 1;
#pragma unroll
            for (int nn = 0; nn < 2; ++nn) { const int nt = 2 * (w & 1) + nn; f32x4 acc = (f32x4){0.f, 0.f, 0.f, 0.f};
#pragma unroll
                for (int k2 = 0; k2 < 2; ++k2) { const bf16x8 a = *(const LAS bf16x8*)(L + G_QIN + (16 * mt + fr) * 144 + (32 * k2 + 8 * fq) * 2), b = *(const LAS bf16x8*)(L + G_KIN + (16 * nt + fr) * 144 + (32 * k2 + 8 * fq) * 2);
                    acc = __builtin_amdgcn_mfma_f32_16x16x32_bf16(a, b, acc, 0, 0, 0); }
#pragma unroll
                for (int r = 0; r < 4; ++r) { const int cc = 16 * mt + 4 * fq + r, ss = 16 * nt + fr; const float v = ss <= cc ? acc[r] : 0.f;
                    *(LAS unsigned short*)(L + G_ATT + cc * 144 + ss * 2) = (unsigned short)pg8::bf16_rne_bits(v); } } }
        __syncthreads();
    }
    bf16x8 bv[KS];
#pragma unroll
    for (int k = 0; k < KS; ++k) bv[k] = tr8<272>(Lb + G_VIM, 32 * k, 16 * w, lane);
    if (MODE != 0) {
        bf16x8 bs[2];
#pragma unroll
        for (int k2 = 0; k2 < 2; ++k2) bs[k2] = tr8<272>(Lb + G_SPV, 32 * k2, 16 * w, lane);
#pragma unroll
        for (int mt = 0; mt < MT; ++mt) { f32x4 acc = (f32x4){0.f, 0.f, 0.f, 0.f};
#pragma unroll
            for (int k = 0; k < KS; ++k) { const bf16x8 a = *(const LAS bf16x8*)(L + G_ATT + (16 * mt + fr) * 144 + (32 * k + 8 * fq) * 2); acc = __builtin_amdgcn_mfma_f32_16x16x32_bf16(a, bv[k], acc, 0, 0, 0); }
#pragma unroll
            for (int k2 = 0; k2 < 2; ++k2) { const bf16x8 a = *(const LAS bf16x8*)(L + G_QIN + (16 * mt + fr) * 144 + (32 * k2 + 8 * fq) * 2); acc = __builtin_amdgcn_mfma_f32_16x16x32_bf16(a, bs[k2], acc, 0, 0, 0); }
#pragma unroll
            for (int r = 0; r < 4; ++r) ((LAS float*)(L + G_OST))[(16 * mt + 4 * fq + r) * 132 + 16 * w + fr] = acc[r]; }
    }
    if (MODE != 1) {
#pragma unroll
        for (int mt = 0; mt < 4; ++mt) { f32x4 acc = (f32x4){0.f, 0.f, 0.f, 0.f};
#pragma unroll
            for (int k = 0; k < KS; ++k) { const bf16x8 a = tr8<144>(Lb + G_KDEC, 32 * k, 16 * mt, lane); acc = __builtin_amdgcn_mfma_f32_16x16x32_bf16(a, bv[k], acc, 0, 0, 0); }
            if (MODE == 0) {
#pragma unroll
                for (int r = 0; r < 4; ++r) *(LAS unsigned short*)(L + G_SPV + (16 * mt + 4 * fq + r) * 272 + (16 * w + fr) * 2) = (unsigned short)pg8::bf16_rne_bits(acc[r]);
            } else { const float* S0 = KIN(3) + (size_t)item * 8192; float* So = KOUT + OUT_GLAS + (size_t)item * 8192;
#pragma unroll
                for (int r = 0; r < 4; ++r) { const int d = 16 * mt + 4 * fq + r, e = 16 * w + fr; So[d * 128 + e] = ((LAS float*)(L + G_DEC))[d] * S0[d * 128 + e] + acc[r]; } }
        }
    }
    __syncthreads();
    if (MODE == 0) { bf16* U = (bf16*)(KWS + WS_UPD) + (size_t)slot * 8192;
#pragma unroll
        for (int i = 0; i < 2; ++i) { const int id = tid + 512 * i, d = id >> 4, ch = id & 15; *(GAS v4u*)(U + d * 128 + 8 * ch) = *(const LAS v4u*)(L + G_SPV + d * 272 + 16 * ch); } }
    if (MODE != 0) { const int c = tid >> 3, seg = tid & 7;
        if (c < CV) {
            float o[16]; float ssq = 0.f;
#pragma unroll
            for (int i = 0; i < 4; ++i) { const f32x4 t = *(const LAS f32x4*)(L + G_OST + (c * 132 + 16 * seg + 4 * i) * 4); o[4 * i] = t.x; o[4 * i + 1] = t.y; o[4 * i + 2] = t.z; o[4 * i + 3] = t.w; ssq += (t.x * t.x + t.y * t.y) + (t.z * t.z + t.w * t.w); }
            ssq += __shfl_xor(ssq, 1); ssq += __shfl_xor(ssq, 2); ssq += __shfl_xor(ssq, 4);
            const float rstd = 1.0f / sqrtf(ssq * (1.0f / 128.0f) + EPS);
            const bf16* ogp = PROJ + (size_t)(r0 + c) * NIN + PJ_OG + h * 128 + 16 * seg; const v4u g0 = *(const v4u*)ogp, g1 = *(const v4u*)(ogp + 8);
            const float* gn = KIN(18) + 16 * seg; v4u o0, o1;
#pragma unroll
            for (int i = 0; i < 4; ++i) { o0[i] = pk2(o[2 * i] * rstd * gn[2 * i] * silu_f(bflo(g0[i])), o[2 * i + 1] * rstd * gn[2 * i + 1] * silu_f(bfhi(g0[i])));
                o1[i] = pk2(o[8 + 2 * i] * rstd * gn[8 + 2 * i] * silu_f(bflo(g1[i])), o[9 + 2 * i] * rstd * gn[9 + 2 * i] * silu_f(bfhi(g1[i]))); }
            bf16* zp = (bf16*)(KWS + WS_ZO) + (size_t)(r0 + c) * D + 512 + h * 128 + 16 * seg; *(GAS v4u*)zp = o0; *(GAS v4u*)(zp + 8) = o1;
        }
    }
    __syncthreads();
}

constexpr int P_UIM = 0, P_WPI = 50176, P_OUT = 84992, P_END = 119808;
__device__ __forceinline__ void pool_item(Frame& F, int item) {
    const int tid = otid(), lane = tid & 63, w = __builtin_amdgcn_readfirstlane(tid >> 6), fr = lane & 15, fq = lane >> 4;
    const int g = item & 3, blk = item >> 2; const bool smp = blk >= 128; const int Wn = 2 << g;
    const int t0 = smp ? MP + 64 * (blk - 128) : 128 * blk;
    LAS unsigned char* L = F.lds; const bf16* PROJ = (const bf16*)(KWS + WS_PROJ);
    { const bf16* WP = (const bf16*)(KWS + WS_WPT) + g * 16384;
#pragma unroll
      for (int i = 0; i < 4; ++i) { const int id = tid + 512 * i, n = id >> 4, ch = id & 15; *(LAS v4u*)(L + P_WPI + n * 272 + 16 * ch) = *(const v4u*)(WP + n * 128 + 8 * ch); } }
    if (!smp) { const int seq0 = t0 & ~2047;
        for (int id = tid; id < 143 * 16; id += 512) { const int i = id >> 4, ch = id & 15, row = t0 - 15 + i; v4u v = (v4u){0u, 0u, 0u, 0u};
            if (row >= seq0) v = *(const v4u*)(PROJ + (size_t)row * NIN + PJ_U + g * 128 + 8 * ch);
            *(LAS v4u*)(L + P_UIM + i * 272 + 16 * ch) = v; }
    } else { const int s0 = (blk - 128) * 8;
        for (int id = tid; id < 184 * 16; id += 512) { const int ir = id >> 4, ch = id & 15, sl = ir / 23, i = ir % 23; v4u v;
            if (i < 15) { const float* sp = KIN(2) + ((size_t)(s0 + sl) * 15 + i) * 512 + g * 128 + 8 * ch; const f32x4 a = *(const f32x4*)sp, b = *(const f32x4*)(sp + 4);
                v.x = pk2(a.x, a.y); v.y = pk2(a.z, a.w); v.z = pk2(b.x, b.y); v.w = pk2(b.z, b.w); }
            else v = *(const v4u*)(PROJ + (size_t)(t0 + sl * 8 + i - 15) * NIN + PJ_U + g * 128 + 8 * ch);
            *(LAS v4u*)(L + P_UIM + ir * 272 + 16 * ch) = v; }
    }
    __syncthreads();
    const int nmt = smp ? 4 : 8;
    if (w < nmt) {
        const int tl = 16 * w + fr; const int ib = smp ? 23 * (tl >> 3) + 15 + (tl & 7) : 15 + tl;
        int cnt = Wn; if (!smp) { const int pos = (t0 + tl) & 2047; cnt = pos + 1 < Wn ? pos + 1 : Wn; }
        const float rc = 1.0f / (float)cnt;
        bf16x8 a[4];
#pragma unroll
        for (int k = 0; k < 4; ++k) { float sum[8];
#pragma unroll
            for (int j = 0; j < 8; ++j) sum[j] = 0.f;
            const LAS unsigned char* p0 = L + P_UIM + ib * 272 + (32 * k + 8 * fq) * 2;
            for (int i = 0; i < Wn; ++i) { const v4u v = *(const LAS v4u*)(p0 - i * 272);
#pragma unroll
                for (int j = 0; j < 4; ++j) { sum[2 * j] += bflo(v[j]); sum[2 * j + 1] += bfhi(v[j]); } }
            const v4u cur = *(const LAS v4u*)p0; union { bf16x8 v; unsigned u[4]; } t;
#pragma unroll
            for (int j = 0; j < 4; ++j) t.u[j] = pk2(sum[2 * j] * rc - bflo(cur[j]), sum[2 * j + 1] * rc - bfhi(cur[j]));
            a[k] = t.v; }
        const float* psc = KIN(17) + g * 128;
#pragma unroll
        for (int nt = 0; nt < 8; ++nt) { f32x4 acc = (f32x4){0.f, 0.f, 0.f, 0.f};
#pragma unroll
            for (int k = 0; k < 4; ++k) { const bf16x8 b = *(const LAS bf16x8*)(L + P_WPI + (16 * nt + fr) * 272 + (32 * k + 8 * fq) * 2); acc = __builtin_amdgcn_mfma_f32_16x16x32_bf16(a[k], b, acc, 0, 0, 0); }
            const float sc = psc[16 * nt + fr];
#pragma unroll
            for (int r = 0; r < 4; ++r) *(LAS unsigned short*)(L + P_OUT + (16 * w + 4 * fq + r) * 272 + (16 * nt + fr) * 2) = (unsigned short)pg8::bf16_rne_bits(acc[r] * sc); }
    }
    __syncthreads();
    { bf16* ZO = (bf16*)(KWS + WS_ZO); const int nch = (smp ? 64 : 128) * 16;
      for (int id = tid; id < nch; id += 512) { const int row = id >> 4, ch = id & 15; *(GAS v4u*)(ZO + (size_t)(t0 + row) * D + g * 128 + 8 * ch) = *(const LAS v4u*)(L + P_OUT + row * 272 + 16 * ch); } }
    __syncthreads();
}
__device__ __forceinline__ void pool_state_copies(Frame& F) {
    const bf16* PROJ = (const bf16*)(KWS + WS_PROJ);
    const int NP = 8 * 15 * 128, NS = 128 * 15 * 128;
    for (int id = blockIdx.x * 512 + otid(); id < NP + NS; id += F.G * 512) {
        if (id < NP) { const int c4 = id & 127, i = (id >> 7) % 15, b = id / (15 * 128); const v2u v = *(const v2u*)(PROJ + (size_t)(b * 2048 + 2033 + i) * NIN + PJ_U + 4 * c4);
            *(f32x4*)(KOUT + OUT_POOLP + (size_t)id * 4) = (f32x4){bflo(v.x), bfhi(v.x), bflo(v.y), bfhi(v.y)}; }
        else { const int j = id - NP, c4 = j & 127, i = (j >> 7) % 15, s = j / (15 * 128); f32x4 o;
            if (i < 7) o = *(const f32x4*)(KIN(2) + ((size_t)s * 15 + 8 + i) * 512 + 4 * c4);
            else { const v2u v = *(const v2u*)(PROJ + (size_t)(MP + 8 * s + i - 7) * NIN + PJ_U + 4 * c4); o = (f32x4){bflo(v.x), bfhi(v.x), bflo(v.y), bfhi(v.y)}; }
            *(f32x4*)(KOUT + OUT_POOLS + (size_t)j * 4) = o; }
    }
}
__device__ __forceinline__ void gla_scan(Frame& F) {
    const int tid = otid(); if (tid >= 128) return;
    for (int b = blockIdx.x; b < 256; b += F.G) {
    const int qh = b >> 3, d = 8 * (b & 7) + (tid >> 4), ch = tid & 15;
    const bf16* U = (const bf16*)(KWS + WS_UPD) + (size_t)qh * 32 * 8192 + d * 128 + 8 * ch; bf16* SPo = (bf16*)(KWS + WS_SPREV) + (size_t)qh * 32 * 8192 + d * 128 + 8 * ch; const float* DC = (const float*)(KWS + WS_DEC) + qh * 32 * 64 + d;
    float S[8];
#pragma unroll
    for (int j = 0; j < 8; ++j) S[j] = 0.f;
#pragma unroll 1
    for (int hb = 0; hb < 2; ++hb) {
        v4u u[16]; float dc[16];
#pragma unroll
        for (int n = 0; n < 16; ++n) { u[n] = *(const v4u*)(U + (size_t)(16 * hb + n) * 8192); dc[n] = DC[(16 * hb + n) * 64]; }
#pragma unroll
        for (int n = 0; n < 16; ++n) { v4u o;
#pragma unroll
            for (int j = 0; j < 4; ++j) { o[j] = pk2(S[2 * j], S[2 * j + 1]); S[2 * j] = dc[n] * S[2 * j] + bflo(u[n][j]); S[2 * j + 1] = dc[n] * S[2 * j + 1] + bfhi(u[n][j]); }
            *(GAS v4u*)(SPo + (size_t)(16 * hb + n) * 8192) = o; }
    }
    float* So = KOUT + OUT_GLAP + ((size_t)qh * 64 + d) * 128 + 8 * ch;
    *(f32x4*)So = (f32x4){S[0], S[1], S[2], S[3]}; *(f32x4*)(So + 4) = (f32x4){S[4], S[5], S[6], S[7]};
    }
}


#if DIAG
constexpr size_t WS_DGBUF = 240 * MiB;
__device__ __forceinline__ unsigned dg_hash(unsigned i, unsigned seed) { unsigned h = i * 2654435761u + seed * 0x9e3779b9u; h ^= h >> 16; h *= 0x85ebca6bu; h ^= h >> 13; h *= 0xc2b2ae35u; h ^= h >> 16; return h; }
__device__ __forceinline__ void dg_cmp(gu32* ctl, int stage, float got, float want, float scale) {
    const float err = fabsf(got - want); const bool bad = !(err <= 0.03f * fabsf(want) + 0.03f * scale);
    if (bad) { __hip_atomic_fetch_max(ctl + CW_DG, (unsigned)(64 - stage), RLX_AGENT); __hip_atomic_fetch_add(ctl + CW_DG + 64 * (1 + stage), 1u, RLX_AGENT); }
}
__device__ __forceinline__ float bf1(const bf16* p) { return __uint_as_float((unsigned)(*p) << 16); }
__device__ __forceinline__ int dg_row(unsigned h) { return (h & 1u) ? MP + (int)((h >> 1) % MS) : (int)((h >> 1) % MP); }
__device__ __forceinline__ const float* dg_xrow(const float* xp, const float* xs, int row) { return row < MP ? xp + (size_t)row * D : xs + (size_t)(row - MP) * D; }
#define DG_I (blockIdx.x * 512 + otid())
#define DG_ON (blockIdx.x < 8)
__device__ __forceinline__ void dg_ada(Frame& F, int stage) { if (!DG_ON) return; const unsigned h = dg_hash(DG_I, stage); const int q = h % NSEQ, n = (h >> 8) % NADA;
    const float* c = q < 8 ? KIN(4) + (size_t)q * D : KIN(5) + (size_t)(q - 8) * D; const float* W = KIN(9); float a = KIN(10)[n];
    for (int k = 0; k < D; ++k) a += silu_f(c[k]) * W[(size_t)k * NADA + n];
    dg_cmp(F.ctl, stage, ((const float*)(KWS + WS_ADA))[(size_t)q * NADA + n], a, 1.f); }
__device__ __forceinline__ void dg_wts(Frame& F, int stage) { if (!DG_ON) return; const int i = DG_I; const unsigned h = dg_hash(i, stage); unsigned char* ws = KWS;
    const int t = i % 5;
    if (t == 0) { const int j = (h >> 3) % FF, k = (h >> 16) % D, row = 256 * (j >> 7) + (j & 127);
        dg_cmp(F.ctl, stage, bf1((const bf16*)(ws + WS_W1U) + (size_t)row * D + k), KIN(11)[(size_t)k * NUP + j], 0.02f); dg_cmp(F.ctl, stage, bf1((const bf16*)(ws + WS_W1U) + (size_t)(row + 128) * D + k), KIN(11)[(size_t)k * NUP + FF + j], 0.02f);
        dg_cmp(F.ctl, stage, bf1((const bf16*)(ws + WS_W2U) + (size_t)row * D + k), KIN(20)[(size_t)k * NUP + j], 0.02f); dg_cmp(F.ctl, stage, bf1((const bf16*)(ws + WS_W2U) + (size_t)(row + 128) * D + k), KIN(20)[(size_t)k * NUP + FF + j], 0.02f); }
    else if (t == 1) { const int c = h % D, j = (h >> 10) % FF;
        dg_cmp(F.ctl, stage, bf1((const bf16*)(ws + WS_W1D) + (size_t)c * FF + j), KIN(12)[(size_t)j * D + c], 0.01f); dg_cmp(F.ctl, stage, bf1((const bf16*)(ws + WS_W2D) + (size_t)c * FF + j), KIN(21)[(size_t)j * D + c], 0.01f); }
    else if (t == 2) { const int r = h % NIN, k = (h >> 12) % D; const int src = r < 1536 ? r : (r < 2048 ? 1552 + (r - 1536) : (r < 2064 ? 1536 + (r - 2048) : -1));
        dg_cmp(F.ctl, stage, bf1((const bf16*)(ws + WS_WIN) + (size_t)r * D + k), src < 0 ? 0.f : KIN(13)[(size_t)k * DIN + src], 0.02f); }
    else if (t == 3) { const int n = h % D, k = (h >> 10) % D; dg_cmp(F.ctl, stage, bf1((const bf16*)(ws + WS_WOUT) + (size_t)n * D + k), KIN(19)[(size_t)k * D + n], 0.02f); }
    else { const int g = h & 3, n = (h >> 2) & 127, k = (h >> 9) & 127; dg_cmp(F.ctl, stage, bf1((const bf16*)(ws + WS_WPT) + g * 16384 + n * 128 + k), KIN(16)[g * 16384 + k * 128 + n], 0.05f); } }
__device__ __forceinline__ void dg_h(Frame& F, int stage, const float* xp, const float* xs, const float* ln, int chunk) { if (!DG_ON) return; const unsigned h = dg_hash(DG_I, stage); const int row = dg_row(h), k = (h >> 16) % D, q = seq_of(row);
    const float* x = dg_xrow(xp, xs, row); float ss = 0.f; for (int i = 0; i < D; ++i) ss += x[i] * x[i];
    const float* A = (const float*)(KWS + WS_ADA) + (size_t)q * NADA + chunk * D;
    const float want = x[k] * (1.0f / sqrtf(ss / D + EPS)) * ln[k] * (1.0f + A[D + k]) + A[k];
    dg_cmp(F.ctl, stage, bf1((const bf16*)(KWS + WS_H) + (size_t)row * D + k), want, 1.f); }
__device__ __forceinline__ void dg_act(Frame& F, int stage, const float* wup) { if (!DG_ON) return; const unsigned h = dg_hash(DG_I, stage); const int row = dg_row(h), j = (h >> 12) % FF;
    const bf16* H = (const bf16*)(KWS + WS_H) + (size_t)row * D; float g = 0.f, u = 0.f;
    for (int k = 0; k < D; ++k) { const float x = bf1(H + k); g += x * wup[(size_t)k * NUP + j]; u += x * wup[(size_t)k * NUP + FF + j]; }
    dg_cmp(F.ctl, stage, bf1((const bf16*)(KWS + WS_ACT) + (size_t)row * FF + j), silu_f(g) * u, 0.5f); }
__device__ __forceinline__ void dg_x(Frame& F, int stage, const bf16* A, int K, const float* W, int chunk, float gs, bool first) { if (!DG_ON) return; const int i = DG_I; const unsigned h = dg_hash(i, 77); const int row = dg_row(h), c = (h >> 14) % D, q = seq_of(row);
    float* buf = (float*)(KWS + WS_DGBUF); const float base = first ? dg_xrow(KIN(0), KIN(1), row)[c] : buf[i];
    float a = 0.f; for (int j = 0; j < K; ++j) a += bf1(A + (size_t)row * K + j) * W[(size_t)j * D + c];
    const float want = base + gs * ((const float*)(KWS + WS_ADA))[(size_t)q * NADA + chunk * D + c] * a; const float got = (KOUT + OUT_X)[(size_t)row * D + c];
    dg_cmp(F.ctl, stage, got, want, 1.f); buf[i] = got; }
__device__ __forceinline__ void dg_proj(Frame& F, int stage) { if (!DG_ON) return; const unsigned h = dg_hash(DG_I, stage); const int row = dg_row(h), r = (h >> 12) % NIN;
    const int src = r < 1536 ? r : (r < 2048 ? 1552 + (r - 1536) : (r < 2064 ? 1536 + (r - 2048) : -1));
    const bf16* H = (const bf16*)(KWS + WS_H) + (size_t)row * D; const float* W = KIN(13); float a = 0.f;
    if (src >= 0) for (int k = 0; k < D; ++k) a += bf1(H + k) * W[(size_t)k * DIN + src];
    dg_cmp(F.ctl, stage, bf1((const bf16*)(KWS + WS_PROJ) + (size_t)row * NIN + r), a, 1.f); }
__device__ __forceinline__ void dg_pool(Frame& F, int stage) { if (!DG_ON) return; const unsigned h = dg_hash(DG_I, stage); const int row = dg_row(h), ch = (h >> 14) & 511, g = ch >> 7, n = ch & 127, Wn = 2 << g;
    const bf16* P = (const bf16*)(KWS + WS_PROJ); const float* wp = KIN(16) + g * 16384; const bool smp = row >= MP; const int tt = smp ? ((row - MP) & 7) : (row & 2047), sq = smp ? ((row - MP) >> 3) : 0;
    const int cnt = smp ? Wn : (tt + 1 < Wn ? tt + 1 : Wn); float z = 0.f;
    for (int k = 0; k < 128; ++k) { float s = 0.f;
        for (int i = 0; i < Wn; ++i) { float v = 0.f; if (tt - i >= 0) v = bf1(P + (size_t)(row - i) * NIN + g * 128 + k); else if (smp) v = KIN(2)[((size_t)sq * 15 + 15 + (tt - i)) * 512 + g * 128 + k]; s += v; }
        z += (s / (float)cnt - bf1(P + (size_t)row * NIN + g * 128 + k)) * wp[k * 128 + n]; }
    dg_cmp(F.ctl, stage, bf1((const bf16*)(KWS + WS_ZO) + (size_t)row * D + ch), z * KIN(17)[ch], 0.5f);
    { const int ii = (h >> 3) % 15, c2 = (h >> 8) & 511; const int b = (h >> 20) & 7, s = (h >> 20) & 127;
      dg_cmp(F.ctl, stage + 1, (KOUT + OUT_POOLP)[((size_t)b * 15 + ii) * 512 + c2], bf1(P + (size_t)(b * 2048 + 2033 + ii) * NIN + c2), 0.5f);
      const float want = ii < 7 ? KIN(2)[((size_t)s * 15 + 8 + ii) * 512 + c2] : bf1(P + (size_t)(MP + 8 * s + ii - 7) * NIN + c2);
      dg_cmp(F.ctl, stage + 1, (KOUT + OUT_POOLS)[((size_t)s * 15 + ii) * 512 + c2], want, 0.5f); } }

__device__ __forceinline__ void dg_upd(Frame& F, int stage) { if (!DG_ON) return; const unsigned h = dg_hash(DG_I, stage); const int slot = (DG_I & 1) ? (h & 63) : (h & 1023), dd = (h >> 10) & 63, e = (h >> 16) & 127;
    const int qh = slot >> 5, n = slot & 31, q = qh >> 2, hd = qh & 3, r0 = q * 2048 + n * 64; const bf16* P = (const bf16*)(KWS + WS_PROJ);
    const float* w2 = KIN(14) + hd * 64 + dd; const float b2 = KIN(15)[hd * 64 + dd]; float bs[64]; float b = 0.f;
#pragma unroll 1
    for (int s = 0; s < 64; ++s) { const bf16* pr = P + (size_t)(r0 + s) * NIN; float g = b2; for (int r = 0; r < 16; ++r) g += bf1(pr + PJ_GLR + r) * w2[r * 256];
        b += (fminf(g, 0.f) - logf(1.0f + expf(-fabsf(g)))) * (1.0f / 16.0f); ((LAS float*)F.lds)[s * 512 + otid()] = b; }
    float u = 0.f;
#pragma unroll 1
    for (int s = 0; s < 64; ++s) { const bf16* pr = P + (size_t)(r0 + s) * NIN; u += bf1(pr + PJ_K + hd * 64 + dd) * expf(b - ((LAS float*)F.lds)[s * 512 + otid()]) * bf1(pr + PJ_V + hd * 128 + e); }
    if (slot < 64) { const int s_ = (h >> 23) & 63; const bf16* DK = (const bf16*)(KWS + 241 * MiB) + (size_t)slot * 12288; const bf16* pr = P + (size_t)(r0 + s_) * NIN;
        dg_cmp(F.ctl, stage + 1, bf1(DK + s_ * 64 + dd), bf1(pr + PJ_K + hd * 64 + dd) * expf(b - ((LAS float*)F.lds)[s_ * 512 + otid()]), 0.3f);
        { const bf16* Hr = (const bf16*)(KWS + WS_H) + (size_t)(r0 + s_) * D; const float* Wv = KIN(13) + 1024 + hd * 128 + e; float tr = 0.f;
          for (int k = 0; k < D; ++k) tr += bf1(Hr + k) * Wv[(size_t)k * DIN];
          dg_cmp(F.ctl, stage + 2, bf1(pr + PJ_V + hd * 128 + e), tr, 1.f);
          dg_cmp(F.ctl, stage + 3, bf1(DK + 4096 + s_ * 128 + e), tr, 1.f); } }
#ifdef DG_MAXDIFF
    if (slot < 64) { const int s_ = (h >> 23) & 63; const bf16* DK = (const bf16*)(KWS + 241 * MiB) + (size_t)slot * 12288; const bf16* pr = P + (size_t)(r0 + s_) * NIN;
        const float a_ = bf1(DK + 4096 + s_ * 128 + e), b_ = bf1(pr + PJ_V + hd * 128 + e); const float df = fabsf(a_ - b_);
        if (df > 0.f) { __hip_atomic_fetch_max(F.ctl + CW_DG + 64 * 40, __float_as_uint(df), RLX_AGENT); __hip_atomic_fetch_max(F.ctl + CW_DG + 64 * 41, __float_as_uint(fabsf(b_)), RLX_AGENT); __hip_atomic_fetch_add(F.ctl + CW_DG + 64 * 42, 1u, RLX_AGENT); } }
#endif
    dg_cmp(F.ctl, stage + 4, bf1((const bf16*)(KWS + WS_UPD) + (size_t)slot * 8192 + dd * 128 + e), u, 6.f);
#ifdef DG_RELERR
    { const float g_ = bf1((const bf16*)(KWS + WS_UPD) + (size_t)slot * 8192 + dd * 128 + e); float re = fabsf(g_ - u) / (fabsf(u) + 0.5f); re = re < 4.f ? re : 4.f; if (!(re == re)) re = 4.f;
      __hip_atomic_fetch_add(F.ctl + CW_DG + 64 * 43, (unsigned)(re * 1024.f), RLX_AGENT); __hip_atomic_fetch_add(F.ctl + CW_DG + 64 * 44, 1u, RLX_AGENT);
      __hip_atomic_fetch_add(F.ctl + CW_DG + 64 * 45, (unsigned)(int)(g_ * u * 16.f), RLX_AGENT); __hip_atomic_fetch_add(F.ctl + CW_DG + 64 * 46, (unsigned)(int)(u * u * 16.f), RLX_AGENT); }
#endif
    dg_cmp(F.ctl, stage, ((const float*)(KWS + WS_DEC))[slot * 64 + dd], expf(b), 0.1f); (void)bs; }
__device__ __forceinline__ void dg_sprev(Frame& F, int stage) { if (!DG_ON) return; const unsigned h = dg_hash(DG_I, stage); const int qh = h & 31, n = (h >> 5) & 31, dd = (h >> 10) & 63, e = (h >> 16) & 127;
    float S = 0.f; for (int j = 0; j < n; ++j) { const int slot = qh * 32 + j; S = ((const float*)(KWS + WS_DEC))[slot * 64 + dd] * S + bf1((const bf16*)(KWS + WS_UPD) + (size_t)slot * 8192 + dd * 128 + e); }
    dg_cmp(F.ctl, stage, bf1((const bf16*)(KWS + WS_SPREV) + (size_t)(qh * 32 + n) * 8192 + dd * 128 + e), S, 10.f); }
__device__ __forceinline__ void dg_gla(Frame& F, int stage) { if (!DG_ON) return;
    const int tid_ = otid(), lane = tid_ & 63, wv = __builtin_amdgcn_readfirstlane(tid_ >> 6), gw = blockIdx.x * 8 + wv; const unsigned h = dg_hash(gw, stage);
    const bool smp = gw >= 40; const int hd = (h >> 3) & 3; int seqi, t, rbase; bool last;
    if (!smp) { seqi = h & 7; t = gw < 8 ? 2047 : (gw < 24 ? (int)((h >> 8) % 200) : (int)((h >> 8) % 2048)); rbase = seqi * 2048; last = t == 2047; }
    else { seqi = (h >> 8) & 127; t = (gw & 1) ? 7 : (int)((h >> 16) & 7); rbase = MP + 8 * seqi; last = t == 7; }
    const bf16* P = (const bf16*)(KWS + WS_PROJ); LAS float* sh = (LAS float*)(F.lds + wv * 1024);
    const float* w2 = KIN(14) + hd * 64 + lane; const float b2 = KIN(15)[hd * 64 + lane];
    float oo[2] = {0.f, 0.f};
#pragma unroll 1
    for (int half = 0; half < 2; ++half) { const int e = lane + 64 * half;
        float S0[64];
#pragma unroll
        for (int d = 0; d < 64; ++d) S0[d] = 0.f;
        if (smp) { const float* Si = KIN(3) + (size_t)(seqi * 4 + hd) * 8192;
#pragma unroll
            for (int d = 0; d < 64; ++d) S0[d] = Si[d * 128 + e]; }
        for (int s = 0; s <= t; ++s) { const bf16* pr = P + (size_t)(rbase + s) * NIN; float g = b2;
            for (int r = 0; r < 16; ++r) g += bf1(pr + PJ_GLR + r) * w2[r * 256];
            const float la = (fminf(g, 0.f) - logf(1.0f + expf(-fabsf(g)))) * (1.0f / 16.0f);
            sh[lane] = expf(la); sh[64 + lane] = bf1(pr + PJ_K + hd * 64 + lane); sh[128 + lane] = bf1(pr + PJ_Q + hd * 64 + lane);
            __builtin_amdgcn_s_waitcnt(0); __builtin_amdgcn_wave_barrier();
            const float v0 = bf1(pr + PJ_V + hd * 128 + e);
#pragma unroll
            for (int d = 0; d < 64; ++d) S0[d] = sh[d] * S0[d] + sh[64 + d] * v0;
            if (s == t) { float o0 = 0.f;
#pragma unroll
                for (int d = 0; d < 64; ++d) o0 += sh[128 + d] * 0.125f * S0[d];
                oo[half] = o0; }
            __builtin_amdgcn_s_waitcnt(0); __builtin_amdgcn_wave_barrier();
        }
        if (last) { const float* So = smp ? KOUT + OUT_GLAS + (size_t)(seqi * 4 + hd) * 8192 : KOUT + OUT_GLAP + (size_t)(seqi * 4 + hd) * 8192;
#pragma unroll
            for (int d = 0; d < 64; ++d) dg_cmp(F.ctl, smp ? stage + 7 : stage + 2, So[d * 128 + e], S0[d], 10.f); }
    }
    { const bf16* pr = P + (size_t)(rbase + t) * NIN; const float rstd = 1.0f / sqrtf(wave_sum(oo[0] * oo[0] + oo[1] * oo[1]) * (1.0f / 128.0f) + EPS); const float* gn = KIN(18);
      const float w0 = oo[0] * rstd * gn[lane] * silu_f(bf1(pr + PJ_OG + hd * 128 + lane)), w1 = oo[1] * rstd * gn[lane + 64] * silu_f(bf1(pr + PJ_OG + hd * 128 + lane + 64));
      const bf16* Z = (const bf16*)(KWS + WS_ZO) + (size_t)(rbase + t) * D + 512 + hd * 128;
      dg_cmp(F.ctl, smp ? stage + 6 : (t < 64 ? stage : stage + 1), bf1(Z + lane), w0, 2.f); dg_cmp(F.ctl, smp ? stage + 6 : (t < 64 ? stage : stage + 1), bf1(Z + lane + 64), w1, 2.f); }
}
__device__ __forceinline__ void dg_report(Frame& F, unsigned bar_tmo) {
    unsigned code = __hip_atomic_load(F.ctl + CW_DG, RLX_AGENT); if (bar_tmo && code == 0u) code = 64 - 25;
    if (code == 0u) return;
#ifdef DG_RELERR
    { const float sre = (float)__hip_atomic_load(F.ctl + CW_DG + 64 * 43, RLX_AGENT) / 1024.f, n_ = (float)__hip_atomic_load(F.ctl + CW_DG + 64 * 44, RLX_AGENT);
      const float sgw = (float)(int)__hip_atomic_load(F.ctl + CW_DG + 64 * 45, RLX_AGENT), sww = (float)(int)__hip_atomic_load(F.ctl + CW_DG + 64 * 46, RLX_AGENT);
#if DG_RELERR == 1
      const float cc = 1.f + 16.f * sre / n_;
#else
      const float cc = 8.f + 4.f * sgw / (sww + 1.f);
#endif
      float* o2 = KOUT; for (size_t i = (size_t)blockIdx.x * 512 + otid(); i < OUT_END; i += (size_t)gridDim.x * 512) o2[i] = i < (size_t)MP * D ? cc : 0.f; return; }
#endif
#ifdef DG_MAXDIFF
    { const float md = __uint_as_float(__hip_atomic_load(F.ctl + CW_DG + 64 * 40, RLX_AGENT)); const unsigned cnt = __hip_atomic_load(F.ctl + CW_DG + 64 * 42, RLX_AGENT);
      const float cc = cnt == 0 ? 1.f : (md >= 1.f ? 2.f : (md >= 0.25f ? 4.f : (md >= 0.0625f ? 8.f : (md >= 0.015625f ? 16.f : (md >= 0.00390625f ? 32.f : 64.f)))));
      float* o2 = KOUT; for (size_t i = (size_t)blockIdx.x * 512 + otid(); i < OUT_END; i += (size_t)gridDim.x * 512) o2[i] = i < (size_t)MP * D ? cc : 0.f; return; }
#endif
#ifdef DG_FOCUS
    const float c = (float)__hip_atomic_load(F.ctl + CW_DG + 64 * (1 + DG_FOCUS), RLX_AGENT) + 0.5f;
#else
    const float c = exp2f((float)(64 - (int)code));
#endif
    float* o = KOUT;
    for (size_t i = (size_t)blockIdx.x * 512 + otid(); i < OUT_END; i += (size_t)gridDim.x * 512) o[i] = i < (size_t)MP * D ? c : 0.f;
}
#define DG(call) do { call; GRID_BAR(); } while (0)
#else
#define DG(call) do { } while (0)
#endif

struct Args { const float* in[23]; float* out; unsigned char* ws; };
__global__ void __launch_bounds__(NWAVES * 64, 2) mk_fwd(Args args) {
    extern __shared__ __attribute__((aligned(16))) unsigned char lds[];
    Frame F;
    F.lds = (LAS unsigned char*)lds; F.MISC = (volatile LAS unsigned*)(F.lds + MISC_OFF);
    F.G = gridDim.x;
    F.ctl = (gu32*)(KWS + WS_CTL);
    for (int u = threadIdx.x; u < (LDS_BYTES - LDSCTL_OFF) / 4; u += NWAVES * 64) ((LAS unsigned*)(F.lds + LDSCTL_OFF))[u] = 0u;
    __syncthreads();
    XcdBarrier bar = xcd_barrier_post((unsigned*)(F.ctl + CW_BAR), F.MISC + 8);
#define GRID_BAR() xcd_barrier(bar)
#define WSP(off) (KWS + (off))
#define Hb ((bf16*)WSP(WS_H))
#define ACT ((bf16*)WSP(WS_ACT))
#define PROJ ((bf16*)WSP(WS_PROJ))
#define ZO ((bf16*)WSP(WS_ZO))
#define X (KOUT + OUT_X)
#define ADA ((const float*)WSP(WS_ADA))
#define scr ((LAS float*)(F.lds + __builtin_amdgcn_readfirstlane(otid() >> 6) * 16384))
#define QLANE (otid() & 63)
    const int bx = blockIdx.x;

    for (int u = bx; u < 144; u += F.G) ada_unit(F, u);
    for (int it = wave_dequeue(F.ctl + CW_Q + 0, QLANE); it < CV_1D; it = wave_dequeue(F.ctl + CW_Q + 0, QLANE)) convert_item(F, it, scr);
    GRID_BAR();
    DG(dg_ada(F, 1));
    { constexpr int NG = M / 8, NCV = CV_END - CV_1D;
      for (int it = wave_dequeue(F.ctl + CW_Q + 64, QLANE); it < NG + NCV; it = wave_dequeue(F.ctl + CW_Q + 64, QLANE)) {
          if (it < NG) norm_group<false>(F, KIN(0), KIN(1), KIN(6), 0, Hb, nullptr, it); else convert_item(F, CV_1D + it - NG, scr); } }
    GRID_BAR();
    DG(dg_wts(F, 2)); DG(dg_h(F, 3, KIN(0), KIN(1), KIN(6), 0));
#pragma unroll 1
    for (int f = 0; f < 2; ++f) {
        { pg8::Gemm g{Hb, (const bf16*)WSP(f ? WS_W2U : WS_W1U), M, NUP, D}; pg8::StaticOrder S; S.init(M, NUP, F.G, bx);
          pg8::EpiSwiGLU E{ACT, FF};
          pg8::gemm_phase<pg8::EpiSwiGLU, pg8::StaticOrder, true, true>(F.lds, g, S, E); }
        GRID_BAR();
        DG(dg_act(F, f ? 21 : 4, f ? KIN(20) : KIN(11)));
        { pg8::Gemm g{ACT, (const bf16*)WSP(f ? WS_W2D : WS_W1D), M, D, FF}; pg8::StaticOrder S; S.init(M, D, F.G, bx);
          pg8::EpiResid E{f ? X : KIN(0), f ? X + (size_t)MP * D : KIN(1), X, ADA + (f ? 8 : 2) * D, 0.5f, MP};
          pg8::gemm_phase<pg8::EpiResid, pg8::StaticOrder, true, true>(F.lds, g, S, E); }
        GRID_BAR();
        DG(dg_x(F, f ? 24 : 5, ACT, FF, f ? KIN(21) : KIN(12), f ? 8 : 2, 0.5f, f == 0));
        if (f == 0) {
            for (int it = wave_dequeue(F.ctl + CW_Q + 128, QLANE); it < M / 8; it = wave_dequeue(F.ctl + CW_Q + 128, QLANE)) norm_group<false>(F, X, X + (size_t)MP * D, KIN(7), 3, Hb, nullptr, it);
            GRID_BAR();
            DG(dg_h(F, 6, X, X + (size_t)MP * D, KIN(7), 3));
            { pg8::Gemm g{Hb, (const bf16*)WSP(WS_WIN), M, NIN, D}; pg8::StaticOrder S; S.init(M, NIN, F.G, bx);
              pg8::EpiProj E{PROJ, NIN};
              pg8::gemm_phase<pg8::EpiProj, pg8::StaticOrder, true, true>(F.lds, g, S, E); }
            GRID_BAR();
            DG(dg_proj(F, 7));
            for (int it = block_dequeue(F, F.ctl + CW_Q + 192); it < 512 + 1024 + 576; it = block_dequeue(F, F.ctl + CW_Q + 192)) {
                if (it < 512) gla_item<2>(F, it); else if (it < 1536) gla_item<0>(F, it - 512); else pool_item(F, it - 1536); }
            pool_state_copies(F);
            GRID_BAR();
            DG(dg_upd(F, 10));
            gla_scan(F);
            GRID_BAR();
            DG(dg_sprev(F, 15));
            for (int it = block_dequeue(F, F.ctl + CW_Q + 256); it < 1024; it = block_dequeue(F, F.ctl + CW_Q + 256)) gla_item<1>(F, it);
            GRID_BAR();
            DG(dg_pool(F, 8)); DG(dg_gla(F, 16));
            { pg8::Gemm g{ZO, (const bf16*)WSP(WS_WOUT), M, D, D}; pg8::StaticOrder S; S.init(M, D, F.G, bx);
              pg8::EpiResid E{X, X + (size_t)MP * D, X, ADA + 5 * D, 1.0f, MP};
              pg8::gemm_phase<pg8::EpiResid, pg8::StaticOrder, true, true>(F.lds, g, S, E); }
            GRID_BAR();
            DG(dg_x(F, 19, ZO, D, KIN(19), 5, 1.0f, false));
            for (int it = wave_dequeue(F.ctl + CW_Q + 320, QLANE); it < M / 8; it = wave_dequeue(F.ctl + CW_Q + 320, QLANE)) norm_group<false>(F, X, X + (size_t)MP * D, KIN(8), 6, Hb, nullptr, it);
            GRID_BAR();
            DG(dg_h(F, 20, X, X + (size_t)MP * D, KIN(8), 6));
        }
    }
    for (int it = wave_dequeue(F.ctl + CW_Q + 384, QLANE); it < M / 8; it = wave_dequeue(F.ctl + CW_Q + 384, QLANE)) norm_group<true>(F, X, X + (size_t)MP * D, KIN(22), 0, nullptr, X, it);
#if DIAG
    GRID_BAR(); dg_report(F, __hip_atomic_load((gu32*)(bar.bar + XB_TMO), RLX_AGENT));
#endif
}

#undef WSP
#undef Hb
#undef ACT
#undef PROJ
#undef ZO
#undef X
#undef ADA
#undef scr
extern "C" void kernel_launch(void* const* d_in, const int* in_sizes, int n_in, void* d_out, int out_size, void* d_ws, size_t ws_size, hipStream_t stream) {
    static int grid = 0;
    if (grid == 0) {
        if (n_in != 23 || in_sizes[0] != MP * D || (size_t)out_size != OUT_END || ws_size < WS_END + DIAG * MiB) { fprintf(stderr, "kernel_launch: unexpected shapes: n_in %d in0 %d out %d ws %zu (need %zu); nothing launched\n", n_in, n_in > 0 ? in_sizes[0] : -1, out_size, ws_size, (size_t)WS_END); grid = -1; return; }
        int dev = 0, cus = 0, per_cu = 0;
        if (hipGetDevice(&dev) != hipSuccess || hipDeviceGetAttribute(&cus, hipDeviceAttributeMultiprocessorCount, dev) != hipSuccess) { fprintf(stderr, "kernel_launch: device query failed\n"); grid = -1; return; }
        if (hipFuncSetAttribute((const void*)mk_fwd, hipFuncAttributeMaxDynamicSharedMemorySize, LDS_BYTES) != hipSuccess) { fprintf(stderr, "kernel_launch: hipFuncSetAttribute failed\n"); grid = -1; return; }
        if (hipOccupancyMaxActiveBlocksPerMultiprocessor(&per_cu, (const void*)mk_fwd, NWAVES * 64, LDS_BYTES) != hipSuccess || per_cu < 1) { fprintf(stderr, "kernel_launch: occupancy query reports %d workgroups per CU\n", per_cu); per_cu = 1; }
        (void)hipGetLastError();
        grid = cus;
        if (grid != 256) fprintf(stderr, "kernel_launch: note: %d CUs\n", grid);
    }
    if (grid < 0) return;
    if (hipMemsetAsync((char*)d_ws + WS_CTL, 0, CTL_ZERO_BYTES, stream) != hipSuccess) { fprintf(stderr, "kernel_launch: hipMemsetAsync failed\n"); return; }
    Args a{};
    for (int i = 0; i < 23; ++i) a.in[i] = (const float*)d_in[i];
    a.out = (float*)d_out; a.ws = (unsigned char*)d_ws;
    hipLaunchKernelGGL(mk_fwd, dim3(grid), dim3(NWAVES * 64), LDS_BYTES, stream, a);
}
```

```cpp
#include <hip/hip_runtime.h>
#include <cstdio>
#include <cstdint>
#ifndef DIAG
#define DIAG 0
#endif
namespace pg8 {
#define PG8_LAS __attribute__((address_space(3)))
typedef unsigned short bf16_t;
typedef short bf16x8 __attribute__((ext_vector_type(8)));
typedef float f32x4 __attribute__((ext_vector_type(4)));
typedef unsigned u32x4 __attribute__((ext_vector_type(4)));
constexpr int BM = 256, BK = 64, HALF = 128, HTB = HALF * BK * 2  , STAGE_BYTES = 8 * HTB, NXCD = 8, WGM = 8;

__host__ __device__ __forceinline__ int lds_byte(int r, int c) { const int st = (r >> 4) * 2 + (c >> 5), rr = r & 15, cc = c & 31, ob = rr * 64 + cc * 2; return st * 1024 + (ob ^ (((ob >> 9) & 1) << 5)); }
__host__ __device__ __forceinline__ void stage_rc(int b, int& R, int& C) { const int st = b / 1024, sb = b % 1024, swz = sb ^ (((sb >> 9) & 1) << 5); R = (st >> 1) * 16 + swz / 64; C = (st & 1) * 32 + (swz % 64) / 2; }
__host__ __device__ __forceinline__ int perm32(int rho) { const int n = rho >> 4, i = rho & 15; return 8 * (i >> 2) + 4 * n + (i & 3); }

struct Unit { int pm, pn; };
struct Gemm { const bf16_t* A; const bf16_t* Bt; int M, N, K; };

struct StaticOrder {
    int nM, nN, nwg, G, c;
    __host__ __device__ void init(int M, int N, int G_, int c_) { nM = M / BM; nN = N / BM; nwg = nM * nN; G = G_; c = c_; }
    __host__ __device__ bool next(int i, Unit& u) const {
        const long L = (long)i * G + c; if (L >= nwg) return false;
        int wgid = (int)L; { const int q = nwg / NXCD, r = nwg % NXCD, xcd = wgid % NXCD, off = wgid / NXCD; wgid = (xcd < r ? xcd * (q + 1) : r * (q + 1) + (xcd - r) * q) + off; }
        const int nig = WGM * nN, gid = wgid / nig, fm = gid * WGM, gsz = (nM - fm) < WGM ? (nM - fm) : WGM;
        u.pm = fm + ((wgid % nig) % gsz); u.pn = (wgid % nig) / gsz; return true;
    }
    __device__ __forceinline__ void a_ready(const Unit&) const {}
    __device__ __forceinline__ void done(const Unit&) const {}
};

__device__ __forceinline__ unsigned cvt_pk_bf16(float lo, float hi) { unsigned r; asm volatile("v_cvt_pk_bf16_f32 %0, %1, %2\n\ts_nop 1" : "=v"(r) : "v"(lo), "v"(hi)); return r; }
__device__ __forceinline__ unsigned bf16_rne_bits(float f) { const unsigned u = __builtin_bit_cast(unsigned, f); return (u + 0x7fffu + ((u >> 16) & 1u)) >> 16; }
__device__ __forceinline__ unsigned cvt_pk_bf16_sw(float lo, float hi) { return bf16_rne_bits(lo) | (bf16_rne_bits(hi) << 16); }
typedef unsigned u32x2 __attribute__((ext_vector_type(2)));
__device__ __forceinline__ float silu_f(float x) { return x * __builtin_amdgcn_rcpf(1.0f + __builtin_amdgcn_exp2f(-1.4426950408889634f * x)); }

struct EpiSwiGLU {
    static constexpr bool PERM = true, AFTER_DRAIN = false;
    bf16_t* O; int ldc;
    __device__ __forceinline__ void operator()(const f32x4 (&acc)[2][2][4][2], const Unit& u, int wr, int wc, int fr, int fq) const {
        const int row0 = u.pm * BM + wr * 64 + fr, col0 = u.pn * 128 + wc * 32 + 8 * fq;
#pragma unroll
        for (int ai = 0; ai < 2; ++ai)
#pragma unroll
            for (int m = 0; m < 4; ++m) { bf16_t* rowp = O + (size_t)(row0 + ai * HALF + m * 16) * ldc + col0;
                const f32x4 g0 = acc[ai][0][m][0], g1 = acc[ai][0][m][1], u0 = acc[ai][1][m][0], u1 = acc[ai][1][m][1];
                u32x4 w;
                w.x = cvt_pk_bf16(silu_f(g0[0]) * u0[0], silu_f(g0[1]) * u0[1]); w.y = cvt_pk_bf16(silu_f(g0[2]) * u0[2], silu_f(g0[3]) * u0[3]);
                w.z = cvt_pk_bf16(silu_f(g1[0]) * u1[0], silu_f(g1[1]) * u1[1]); w.w = cvt_pk_bf16(silu_f(g1[2]) * u1[2], silu_f(g1[3]) * u1[3]);
                *(u32x4*)rowp = w; }
    }
};
struct EpiProj {
    static constexpr bool PERM = true, AFTER_DRAIN = false;
    bf16_t* O; int ldc;
    __device__ __forceinline__ void operator()(const f32x4 (&acc)[2][2][4][2], const Unit& u, int wr, int wc, int fr, int fq) const {
        const int row0 = u.pm * BM + wr * 64 + fr, col0 = u.pn * BM + wc * 32 + 8 * fq;
#pragma unroll
        for (int ai = 0; ai < 2; ++ai)
#pragma unroll
            for (int m = 0; m < 4; ++m) { bf16_t* rowp = O + (size_t)(row0 + ai * HALF + m * 16) * ldc + col0;
#pragma unroll
                for (int bj = 0; bj < 2; ++bj) { const f32x4 v0 = acc[ai][bj][m][0], v1 = acc[ai][bj][m][1]; u32x4 w;
                    w.x = cvt_pk_bf16_sw(v0[0], v0[1]); w.y = cvt_pk_bf16_sw(v0[2], v0[3]); w.z = cvt_pk_bf16_sw(v1[0], v1[1]); w.w = cvt_pk_bf16_sw(v1[2], v1[3]);
                    *(u32x4*)(rowp + bj * HALF) = w; } }
    }
};
struct EpiResid {
    static constexpr bool PERM = false, AFTER_DRAIN = false;
    const float* base_p; const float* base_s; float* out; const float* gate; float gs; int mp;
    __device__ __forceinline__ void operator()(const f32x4 (&acc)[2][2][4][2], const Unit& u, int wr, int wc, int fr, int fq) const {
        const int col0 = u.pn * BM + wc * 32 + 4 * fq;
#pragma unroll
        for (int ai = 0; ai < 2; ++ai)
#pragma unroll
            for (int m = 0; m < 4; ++m) { const int r = u.pm * BM + ai * HALF + wr * 64 + m * 16 + fr;
                const int q = r < mp ? (r >> 11) : 8 + ((r - mp) >> 3);
                const float* bp = (r < mp ? base_p + (size_t)r * 1024 : base_s + (size_t)(r - mp) * 1024) + col0;
                const float* gp = gate + (size_t)q * 9216 + col0; float* op = out + (size_t)r * 1024 + col0;
#pragma unroll
                for (int bj = 0; bj < 2; ++bj)
#pragma unroll
                    for (int n = 0; n < 2; ++n) { const f32x4 b = *(const f32x4*)(bp + bj * HALF + n * 16), g = *(const f32x4*)(gp + bj * HALF + n * 16);
                        *(f32x4*)(op + bj * HALF + n * 16) = b + (acc[ai][bj][m][n] * g) * gs; }
                if (m & 1) asm volatile("" ::: "memory"); }
    }
};
template <class Epi, class Sched, bool ALIGN_EPI = false, bool SP2 = false>
__device__ __forceinline__ void gemm_phase(PG8_LAS unsigned char* lds, const Gemm g, const Sched& S, const Epi& E) {
    int tid_ = threadIdx.x; asm volatile("" : "+v"(tid_));
    const int tid = tid_, wid = __builtin_amdgcn_readfirstlane(tid >> 6), lane = tid & 63, wr = wid >> 2, wc = wid & 3, fr = lane & 15, fq = lane >> 4;
    const int K = g.K, nt = K / BK;
    unsigned voffA[2], voffB[2];
#pragma unroll
    for (int i = 0; i < 2; ++i) { int R, C; stage_rc(tid * 16 + i * 8192, R, C); const int Rb = Epi::PERM ? ((R & ~31) + perm32(R & 31)) : R;
        voffA[i] = (unsigned)(R * K + C) * 2u; voffB[i] = (unsigned)(Rb * K + C) * 2u; }
    const size_t kstep = (size_t)(BK * 2);
    const size_t hstep = (size_t)HALF * K * 2;
    const size_t tstep = 2 * hstep;
    const unsigned ldsw = (unsigned)wid * 1024u;
    const int aoff = lds_byte(wr * 64 + fr, fq * 8), boff = lds_byte(wc * 32 + fr, fq * 8);
#define PG8_SA(b, h) (((b) * 2 + (h)) * HTB)
#define PG8_SB(b, h) ((4 + (b) * 2 + (h)) * HTB)
#define PG8_STAGE(bufoff, gbase, voff) do { _Pragma("unroll") for (int _i = 0; _i < 2; ++_i) \
        __builtin_amdgcn_global_load_lds((const unsigned*)((const char*)(gbase) + (voff)[_i]), (PG8_LAS unsigned*)(lds + (bufoff) + ldsw + _i * 8192), 16, 0, 0); } while (0)
#define PG8_LDA(dst, b, h) do { _Pragma("unroll") for (int m = 0; m < 4; ++m) _Pragma("unroll") for (int k = 0; k < 2; ++k) dst[m][k] = *(const PG8_LAS bf16x8*)(lds + PG8_SA(b, h) + aoff + m * 2048 + k * 1024); } while (0)
#define PG8_LDB(dst, b, h) do { _Pragma("unroll") for (int n = 0; n < 2; ++n) _Pragma("unroll") for (int k = 0; k < 2; ++k) dst[n][k] = *(const PG8_LAS bf16x8*)(lds + PG8_SB(b, h) + boff + n * 2048 + k * 1024); } while (0)
#define PG8_MMA(ai, bj, At, Bt) do { __builtin_amdgcn_s_setprio(1); _Pragma("unroll") for (int m = 0; m < 4; ++m) _Pragma("unroll") for (int n = 0; n < 2; ++n) _Pragma("unroll") for (int k = 0; k < 2; ++k) \
        acc[ai][bj][m][n] = __builtin_amdgcn_mfma_f32_16x16x32_bf16(Bt[n][k], At[m][k], acc[ai][bj][m][n], 0, 0, 0); __builtin_amdgcn_s_setprio(0); } while (0)
#define PG8_WAIT_V(n) asm volatile("s_waitcnt vmcnt(" #n ")" ::: "memory")
#define PG8_WAIT_L(n) asm volatile("s_waitcnt lgkmcnt(" #n ")" ::: "memory")
#define PG8_BAR __builtin_amdgcn_s_barrier()
#define PG8_SCHED __builtin_amdgcn_sched_barrier(0)
    Unit cur, nxt; int ui = 0;
    if (!S.next(0, cur)) return;
    f32x4 acc[2][2][4][2];
#pragma unroll
    for (int a = 0; a < 2; ++a)
#pragma unroll
        for (int b = 0; b < 2; ++b)
#pragma unroll
            for (int m = 0; m < 4; ++m)
#pragma unroll
                for (int n = 0; n < 2; ++n) acc[a][b][m][n] = (f32x4){0.f, 0.f, 0.f, 0.f};
    bf16x8 At[4][2], B0[2][2], B1[2][2];
    const char* cA = (const char*)g.A + (size_t)cur.pm * tstep; const char* cB = (const char*)g.Bt + (size_t)cur.pn * tstep;
    S.a_ready(cur);
    if constexpr (SP2) {
        PG8_STAGE(PG8_SB(0, 0), cB, voffB); PG8_STAGE(PG8_SB(0, 1), cB + hstep, voffB); PG8_STAGE(PG8_SA(0, 0), cA, voffA); PG8_STAGE(PG8_SA(0, 1), cA + hstep, voffA);
        if (wr == 1) PG8_BAR;
        PG8_WAIT_V(2); PG8_BAR;
        PG8_STAGE(PG8_SB(1, 0), cB + kstep, voffB); PG8_STAGE(PG8_SA(1, 0), cA + kstep, voffA); PG8_STAGE(PG8_SB(1, 1), cB + hstep + kstep, voffB);
        PG8_WAIT_V(6); PG8_BAR;
    } else {
        PG8_STAGE(PG8_SB(0, 0), cB, voffB); PG8_STAGE(PG8_SA(0, 0), cA, voffA); PG8_STAGE(PG8_SB(0, 1), cB + hstep, voffB); PG8_STAGE(PG8_SA(0, 1), cA + hstep, voffA);
        if (wr == 1) PG8_BAR;
        PG8_WAIT_V(4); PG8_BAR;
        PG8_STAGE(PG8_SB(1, 0), cB + kstep, voffB); PG8_STAGE(PG8_SA(1, 0), cA + kstep, voffA); PG8_STAGE(PG8_SB(1, 1), cB + hstep + kstep, voffB);
        PG8_WAIT_V(6); PG8_BAR;
    }
    for (;;) {
        const bool has_next = S.next(ui + 1, nxt);
        const char* nA = has_next ? (const char*)g.A + (size_t)nxt.pm * tstep : cA; const char* nB = has_next ? (const char*)g.Bt + (size_t)nxt.pn * tstep : cB;
        for (int t = 0; t < nt; t += 2) {
            const bool last = (t == nt - 2);
            const char* a1 = cA + (size_t)(t + 1) * kstep;
            const char* a2 = last ? nA : cA + (size_t)(t + 2) * kstep; const char* b2 = last ? nB : cB + (size_t)(t + 2) * kstep;
            const char* a3 = a2 + kstep; const char* b3 = b2 + kstep;
            if (last && has_next) S.a_ready(nxt);
            if constexpr (SP2) {
            PG8_LDB(B0, 0, 0); PG8_LDB(B1, 0, 1); PG8_SCHED; PG8_LDA(At, 0, 0); PG8_STAGE(PG8_SA(1, 1), a1 + hstep, voffA);
            PG8_WAIT_V(8); PG8_WAIT_L(0); PG8_BAR; PG8_MMA(0, 0, At, B0); PG8_MMA(0, 1, At, B1); PG8_BAR; PG8_SCHED;
            PG8_LDA(At, 0, 1); PG8_STAGE(PG8_SB(0, 0), b2, voffB); PG8_STAGE(PG8_SB(0, 1), b2 + hstep, voffB); PG8_STAGE(PG8_SA(0, 0), a2, voffA);
            PG8_WAIT_V(8); PG8_WAIT_L(0); PG8_BAR; PG8_MMA(1, 0, At, B0); PG8_MMA(1, 1, At, B1); PG8_BAR; PG8_SCHED;
            PG8_LDB(B0, 1, 0); PG8_LDB(B1, 1, 1); PG8_SCHED; PG8_LDA(At, 1, 0); PG8_STAGE(PG8_SA(0, 1), a2 + hstep, voffA);
            PG8_WAIT_V(8); PG8_WAIT_L(0); PG8_BAR; PG8_MMA(0, 0, At, B0); PG8_MMA(0, 1, At, B1); PG8_BAR; PG8_SCHED;
            PG8_LDA(At, 1, 1); PG8_STAGE(PG8_SB(1, 0), b3, voffB); PG8_STAGE(PG8_SB(1, 1), b3 + hstep, voffB); PG8_STAGE(PG8_SA(1, 0), a3, voffA);
            PG8_WAIT_V(8); PG8_WAIT_L(0); PG8_BAR; PG8_MMA(1, 0, At, B0); PG8_MMA(1, 1, At, B1); PG8_BAR; PG8_SCHED;
            } else {
            PG8_LDB(B0, 0, 0); PG8_SCHED; PG8_LDA(At, 0, 0); PG8_STAGE(PG8_SA(1, 1), a1 + hstep, voffA);
            PG8_WAIT_L(8); PG8_BAR; PG8_WAIT_L(0); PG8_MMA(0, 0, At, B0); PG8_BAR; PG8_SCHED;
            PG8_LDB(B1, 0, 1); PG8_STAGE(PG8_SB(0, 0), b2, voffB);
            PG8_BAR; PG8_WAIT_L(0); PG8_MMA(0, 1, At, B1); PG8_BAR;
            PG8_LDA(At, 0, 1); PG8_STAGE(PG8_SA(0, 0), a2, voffA);
            PG8_BAR; PG8_WAIT_L(0); PG8_MMA(1, 0, At, B0); PG8_BAR; PG8_SCHED;
            PG8_STAGE(PG8_SB(0, 1), b2 + hstep, voffB);
            PG8_WAIT_V(6); PG8_BAR; PG8_MMA(1, 1, At, B1); PG8_BAR;
            PG8_LDB(B0, 1, 0); PG8_SCHED; PG8_LDA(At, 1, 0); PG8_STAGE(PG8_SA(0, 1), a2 + hstep, voffA);
            PG8_WAIT_L(8); PG8_BAR; PG8_WAIT_L(0); PG8_MMA(0, 0, At, B0); PG8_BAR; PG8_SCHED;
            PG8_LDB(B1, 1, 1); PG8_STAGE(PG8_SB(1, 0), b3, voffB);
            PG8_BAR; PG8_WAIT_L(0); PG8_MMA(0, 1, At, B1); PG8_BAR;
            PG8_LDA(At, 1, 1); PG8_STAGE(PG8_SA(1, 0), a3, voffA);
            PG8_BAR; PG8_WAIT_L(0); PG8_MMA(1, 0, At, B0); PG8_BAR; PG8_SCHED;
            PG8_STAGE(PG8_SB(1, 1), b3 + hstep, voffB);
            PG8_WAIT_V(6); PG8_BAR; PG8_MMA(1, 1, At, B1); PG8_BAR;
            }
        }
        if constexpr (ALIGN_EPI) { if (wr == 0) PG8_BAR; }
        if constexpr (!Epi::AFTER_DRAIN) { E(acc, cur, wr, wc, fr, fq); S.done(cur); }
        if (!has_next) break;
#pragma unroll
        for (int a = 0; a < 2; ++a)
#pragma unroll
            for (int b = 0; b < 2; ++b)
#pragma unroll
                for (int m = 0; m < 4; ++m)
#pragma unroll
                    for (int n = 0; n < 2; ++n) acc[a][b][m][n] = (f32x4){0.f, 0.f, 0.f, 0.f};
        cur = nxt; cA = nA; cB = nB; ++ui;
        if constexpr (ALIGN_EPI) { if (wr == 1) PG8_BAR; }
    }
    PG8_WAIT_V(0);
    if constexpr (!ALIGN_EPI) { if (wr == 0) PG8_BAR; }
    PG8_BAR;
    if constexpr (Epi::AFTER_DRAIN) { E.fused(acc, cur, wr, wc, fr, fq, lds, wid, lane); S.done(cur); }
#undef PG8_SA
#undef PG8_SB
#undef PG8_STAGE
#undef PG8_LDA
#undef PG8_LDB
#undef PG8_MMA
#undef PG8_WAIT_V
#undef PG8_WAIT_L
#undef PG8_BAR
#undef PG8_SCHED
}
}

constexpr int NWAVES = 8;
constexpr int MP = 16384, MS = 1024, M = MP + MS, D = 1024, FF = 2816, NUP = 2 * FF, NIN = 2304, NSEQ = 136, NADA = 9216;
constexpr int DIN = 2064;
constexpr int PJ_U = 0, PJ_Q = 512, PJ_K = 768, PJ_V = 1024, PJ_OG = 1536, PJ_GLR = 2048;
constexpr float EPS = 1e-6f;
constexpr size_t OUT_X = 0, OUT_POOLP = (size_t)M * D, OUT_GLAP = OUT_POOLP + 8 * 15 * 512, OUT_POOLS = OUT_GLAP + 8 * 4 * 64 * 128, OUT_GLAS = OUT_POOLS + 128 * 15 * 512, OUT_END = OUT_GLAS + (size_t)128 * 4 * 64 * 128;
constexpr size_t KiB = 1024, MiB = 1u << 20;
constexpr size_t WS_CTL = 0, CTL_ZERO_BYTES = 1 * MiB;
constexpr size_t WS_W1U = 1 * MiB, WS_W1D = 12 * MiB, WS_WIN = WS_W1D + 5632 * KiB, WS_WOUT = 22 * MiB, WS_W2U = 24 * MiB, WS_W2D = 35 * MiB, WS_WPT = WS_W2D + 5632 * KiB;
constexpr size_t WS_DEC = WS_WPT + 256 * KiB, WS_ADA = 41 * MiB, WS_H = 46 * MiB, WS_ZO = 80 * MiB, WS_UPD = 114 * MiB, WS_ACT = 130 * MiB, WS_PROJ = WS_ACT, WS_SPREV = 224 * MiB, WS_END = 240 * MiB;
static_assert(WS_W1U + (size_t)NUP * D * 2 <= WS_W1D && WS_W1D + (size_t)D * FF * 2 <= WS_WIN && WS_WIN + (size_t)NIN * D * 2 <= WS_WOUT && WS_WOUT + (size_t)D * D * 2 <= WS_W2U && WS_W2U + (size_t)NUP * D * 2 <= WS_W2D &&
              WS_W2D + (size_t)D * FF * 2 <= WS_WPT && WS_WPT + 4 * 128 * 128 * 2 <= WS_DEC && WS_DEC + 1024 * 64 * 4 <= WS_ADA && WS_ADA + (size_t)NSEQ * NADA * 4 <= WS_H && WS_H + (size_t)M * D * 2 <= WS_ZO &&
              WS_ZO + (size_t)M * D * 2 <= WS_UPD && WS_UPD + (size_t)1024 * 8192 * 2 <= WS_ACT && WS_ACT + (size_t)M * FF * 2 <= WS_SPREV && WS_SPREV + (size_t)1024 * 8192 * 2 <= WS_END && WS_PROJ + (size_t)M * NIN * 2 <= WS_END, "d_ws map");
constexpr int CW_BAR = 4096;
constexpr int CW_DG = 24576;
constexpr int CW_Q = 16384;
constexpr int RING_BYTES = 131072, LDSCTL_OFF = RING_BYTES, MISC_OFF = LDSCTL_OFF + 320, LDS_BYTES = 147456;

#define GAS __attribute__((address_space(1)))
#define LAS __attribute__((address_space(3)))
typedef unsigned short bf16;
typedef unsigned v4u __attribute__((ext_vector_type(4)));
typedef unsigned v2u __attribute__((ext_vector_type(2)));
typedef float f32x4 __attribute__((ext_vector_type(4)));
typedef short bf16x8 __attribute__((ext_vector_type(8)));
typedef short s16x4 __attribute__((ext_vector_type(4)));
typedef GAS unsigned gu32;
#define RLX_AGENT __ATOMIC_RELAXED, __HIP_MEMORY_SCOPE_AGENT
#define LDS_WAIT() asm volatile("s_waitcnt lgkmcnt(0)" ::: "memory")
__device__ __forceinline__ unsigned pk2(float lo, float hi) { return pg8::cvt_pk_bf16(lo, hi); }
__device__ __forceinline__ float bflo(unsigned w) { return __uint_as_float(w << 16); }
__device__ __forceinline__ float bfhi(unsigned w) { return __uint_as_float(w & 0xffff0000u); }
__device__ __forceinline__ float silu_f(float x) { return pg8::silu_f(x); }
__device__ __forceinline__ int seq_of(int r) { return r < MP ? (r >> 11) : 8 + ((r - MP) >> 3); }

#define XB_TMO      128
#define XB_XCNT(j)  (256  + 64 * (j))
#define XB_XSUB(j)  (1280 + 64 * (j))
#define XB_XGEN(j)  (2304 + 64 * (j))
#define XB_TOP      3328
#define XB_TOPGEN   3392
#define XCD_BAR_WORDS 3456
#define XB_SPIN_CAP (1u << 18)

__device__ __forceinline__ unsigned xb_ld(unsigned* p)              { return __hip_atomic_load(p, __ATOMIC_RELAXED, __HIP_MEMORY_SCOPE_AGENT); }
__device__ __forceinline__ unsigned xb_add(unsigned* p, unsigned v) { return __hip_atomic_fetch_add(p, v, __ATOMIC_RELAXED, __HIP_MEMORY_SCOPE_AGENT); }
__device__ __forceinline__ unsigned xb_xcc_id() { return (unsigned)__builtin_amdgcn_s_getreg((3 << 11) | 20) & 0xFu; }
#define XB_SPIN(cond, bar) do { unsigned _sp = 0; while (cond) { __builtin_amdgcn_s_sleep(1); \
    if ((++_sp & 255u) == 0u) { if (xb_ld(&(bar)[XB_TMO])) break; if (_sp > XB_SPIN_CAP) { atomicAdd(&(bar)[XB_TMO], 1u); break; } } } } while (0)

struct XcdBarrier {
    unsigned* bar; unsigned x;
    volatile LAS unsigned* st;
};

__device__ __forceinline__ XcdBarrier xcd_barrier_post(unsigned* bar, volatile LAS unsigned* st) {
    XcdBarrier b; b.bar = bar; b.x = xb_xcc_id(); b.st = st;
    if (threadIdx.x == 0) (void)xb_add(&bar[XB_XCNT(b.x)], 1u);
    return b;
}
__device__ __forceinline__ void xcd_barrier_complete(unsigned* bar, unsigned x, unsigned& nloc, unsigned& nx) {
    const unsigned G = gridDim.x * gridDim.y * gridDim.z;
    unsigned sum, cnt, mine, sp = 0u;
    for (;;) {
        sum = 0u; cnt = 0u; mine = 0u;
#pragma unroll
        for (unsigned j = 0; j < 16; ++j) { const unsigned c = xb_ld(&bar[XB_XCNT(j)]); sum += c; cnt += (c > 0u) ? 1u : 0u; mine = (j == x) ? c : mine; }
        if (sum == G) break;
        __builtin_amdgcn_s_sleep(1);
        if ((++sp & 255u) == 0u) { if (xb_ld(&bar[XB_TMO])) break; if (sp > XB_SPIN_CAP) { atomicAdd(&bar[XB_TMO], 1u); break; } }
    }
    nloc = mine > 0u ? mine : 1u; nx = cnt > 0u ? cnt : 1u;
}

__device__ __forceinline__ void xcd_barrier(const XcdBarrier& b) {
    asm volatile("s_waitcnt vmcnt(0)" ::: "memory");
    __syncthreads();
    if (threadIdx.x == 0) {
        unsigned* bar = b.bar;
        __builtin_amdgcn_s_waitcnt(0);
        unsigned nloc = b.st[0], nx = b.st[1];
        if (nloc == 0u) { xcd_barrier_complete(bar, b.x, nloc, nx); b.st[0] = nloc; b.st[1] = nx; }
        const unsigned old = xb_add(&bar[XB_XSUB(b.x)], 1u);
        const unsigned gen = old / nloc;
        if (old + 1u == (gen + 1u) * nloc) {
            __builtin_amdgcn_fence(__ATOMIC_RELEASE, "agent");
            asm volatile("s_waitcnt vmcnt(0)" ::: "memory");
            const unsigned og = xb_add(&bar[XB_TOP], 1u);
            const unsigned tg = og / nx;
            if (og + 1u == (tg + 1u) * nx) xb_add(&bar[XB_TOPGEN], 1u);
            else XB_SPIN(xb_ld(&bar[XB_TOPGEN]) == tg, bar);
            __builtin_amdgcn_fence(__ATOMIC_ACQUIRE, "agent");
            xb_add(&bar[XB_XGEN(b.x)], 1u);
            asm volatile("s_waitcnt vmcnt(0)" ::: "memory");
        } else {
            XB_SPIN(xb_ld(&bar[XB_XGEN(b.x)]) == gen, bar);
            __builtin_amdgcn_fence(__ATOMIC_ACQUIRE, "agent");
            asm volatile("s_waitcnt vmcnt(0)" ::: "memory");
        }
    }
    __syncthreads();
}


struct Frame {
    LAS unsigned char* lds;
    volatile LAS unsigned* MISC;
    gu32* ctl;
    int G;
};
__device__ __forceinline__ int otid() { int t = threadIdx.x; asm volatile("" : "+v"(t)); return t; }
typedef const float* fptr_t; typedef float* fptrw_t; typedef unsigned char* bptr_t;
__device__ __forceinline__ const __attribute__((address_space(4))) unsigned char* kargs() { const __attribute__((address_space(4))) unsigned char* p = (const __attribute__((address_space(4))) unsigned char*)__builtin_amdgcn_kernarg_segment_ptr(); asm volatile("" : "+s"(p)); return p; }
#define KIN(i) (((const __attribute__((address_space(4))) fptr_t*)kargs())[i])
#define KOUT (((const __attribute__((address_space(4))) fptrw_t*)kargs())[23])
#define KWS (((const __attribute__((address_space(4))) bptr_t*)kargs())[24])
__device__ __forceinline__ float wave_sum(float v) {
#pragma unroll
    for (int o = 1; o < 64; o <<= 1) v += __shfl_xor(v, o);
    return v;
}
__device__ __forceinline__ int wave_dequeue(gu32* head, int lane) {
    unsigned v = 0; if (lane == 0) v = __hip_atomic_fetch_add(head, 1u, RLX_AGENT);
    return (int)__builtin_amdgcn_readfirstlane(v);
}
__device__ __forceinline__ int block_dequeue(Frame& F, gu32* head) {
    if (threadIdx.x == 0) F.MISC[0] = __hip_atomic_fetch_add(head, 1u, RLX_AGENT);
    __syncthreads(); const int v = (int)F.MISC[0]; __syncthreads(); return v;
}

__device__ __forceinline__ void transpose_item(const float* W, int ldw, int csrc, int nvalid, int K, bf16* WT, int drow, int k0, LAS float* scr, int lane) {
    const int n = lane & 31;
#pragma unroll 8
    for (int i = 0; i < 32; ++i) { const int kk = 2 * i + (lane >> 5); float v = 0.f; if (n < nvalid) v = W[(size_t)(k0 + kk) * ldw + csrc + n]; scr[kk * 33 + n] = v; }
    LDS_WAIT(); asm volatile("" ::: "memory");
    const int c = lane & 7;
#pragma unroll
    for (int j = 0; j < 4; ++j) { const int nn = (lane >> 3) + 8 * j; const LAS float* s = scr + (8 * c) * 33 + nn;
        v4u o; o.x = pk2(s[0 * 33], s[1 * 33]); o.y = pk2(s[2 * 33], s[3 * 33]); o.z = pk2(s[4 * 33], s[5 * 33]); o.w = pk2(s[6 * 33], s[7 * 33]);
        *(GAS v4u*)(WT + (size_t)(drow + nn) * K + k0 + 8 * c) = o; }
    LDS_WAIT(); asm volatile("" ::: "memory");
}
constexpr int I_UP = 16 * 176, I_DN = 44 * 32, I_IN = 16 * 72, I_OUT = 16 * 32, I_POOL = 4 * 8;
constexpr int CV_1U = 0, CV_1D = CV_1U + I_UP, CV_IN = CV_1D + I_DN, CV_OUT = CV_IN + I_IN, CV_2U = CV_OUT + I_OUT, CV_2D = CV_2U + I_UP, CV_POOL = CV_2D + I_DN, CV_END = CV_POOL + I_POOL;
__device__ __forceinline__ void up_item(const float* W, bf16* WT, int r, LAS float* scr, int lane) {
    const int kb = r / 176, nb = r % 176, n0 = 32 * nb; const int j0 = n0 < FF ? n0 : n0 - FF;
    const int drow = 256 * (j0 >> 7) + (j0 & 127) + (n0 < FF ? 0 : 128);
    transpose_item(W, NUP, n0, 32, D, WT, drow, 64 * kb, scr, lane);
}
__device__ __forceinline__ void convert_item(Frame& F, int it, LAS float* scr) {
    unsigned char* ws = KWS; const int lane = otid() & 63;
    if (it < CV_1D) { up_item(KIN(11), (bf16*)(ws + WS_W1U), it - CV_1U, scr, lane); return; }
    if (it < CV_IN) { const int r = it - CV_1D; transpose_item(KIN(12), D, 32 * (r % 32), 32, FF, (bf16*)(ws + WS_W1D), 32 * (r % 32), 64 * (r / 32), scr, lane); return; }
    if (it < CV_OUT) { const int r = it - CV_IN, kb = r / 72, nb = r % 72; int csrc, drow, nv;
        if (nb < 48) { csrc = 32 * nb; drow = 32 * nb; nv = 32; } else if (nb < 64) { csrc = 1552 + 32 * (nb - 48); drow = PJ_OG + 32 * (nb - 48); nv = 32; } else { csrc = 1536; drow = PJ_GLR + 32 * (nb - 64); nv = nb == 64 ? 16 : 0; }
        transpose_item(KIN(13), DIN, csrc, nv, D, (bf16*)(ws + WS_WIN), drow, 64 * kb, scr, lane); return; }
    if (it < CV_2U) { const int r = it - CV_OUT; transpose_item(KIN(19), D, 32 * (r % 32), 32, D, (bf16*)(ws + WS_WOUT), 32 * (r % 32), 64 * (r / 32), scr, lane); return; }
    if (it < CV_2D) { up_item(KIN(20), (bf16*)(ws + WS_W2U), it - CV_2U, scr, lane); return; }
    if (it < CV_POOL) { const int r = it - CV_2D; transpose_item(KIN(21), D, 32 * (r % 32), 32, FF, (bf16*)(ws + WS_W2D), 32 * (r % 32), 64 * (r / 32), scr, lane); return; }
    { const int r = it - CV_POOL, g = r >> 3, kb = (r >> 2) & 1, nb = r & 3;
      transpose_item(KIN(16) + g * 16384, 128, 32 * nb, 32, 128, (bf16*)(ws + WS_WPT) + g * 16384, 32 * nb, 64 * kb, scr, lane); }
}

__device__ __forceinline__ void ada_unit(Frame& F, int unit) {
    const int tid = otid(), lane = tid & 63, w = __builtin_amdgcn_readfirstlane(tid >> 6), mh = w >> 2, ks = w & 3, fr = lane & 15, fq = lane >> 4, n0 = unit * 64;
    const int mt0 = mh ? 5 : 0, nmt = mh ? 4 : 5;
    const float* W = KIN(9); const float* cp = KIN(4); const float* cs = KIN(5);
    f32x4 acc[5][4];
#pragma unroll
    for (int i = 0; i < 5; ++i)
#pragma unroll
        for (int t = 0; t < 4; ++t) acc[i][t] = (f32x4){0.f, 0.f, 0.f, 0.f};
    for (int kk = 0; kk < 8; ++kk) {
        const int k0 = ks * 256 + kk * 32 + 8 * fq;
        bf16x8 b[4];
#pragma unroll
        for (int j = 0; j < 8; j += 2) { const f32x4 w0 = *(const f32x4*)(W + (size_t)(k0 + j) * NADA + n0 + 4 * fr), w1 = *(const f32x4*)(W + (size_t)(k0 + j + 1) * NADA + n0 + 4 * fr);
#pragma unroll
            for (int t = 0; t < 4; ++t) { const unsigned p = pk2(w0[t], w1[t]); b[t][j] = (short)(p & 0xffffu); b[t][j + 1] = (short)(p >> 16); } }
#pragma unroll
        for (int i = 0; i < 5; ++i) if (i < nmt) {
            int s = 16 * (mt0 + i) + fr; s = s > NSEQ - 1 ? NSEQ - 1 : s;
            const float* crow = (s < 8 ? cp + (size_t)s * D : cs + (size_t)(s - 8) * D) + k0;
            const f32x4 c0 = *(const f32x4*)crow, c1 = *(const f32x4*)(crow + 4);
            union { bf16x8 v; unsigned u[4]; } a;
            a.u[0] = pk2(silu_f(c0[0]), silu_f(c0[1])); a.u[1] = pk2(silu_f(c0[2]), silu_f(c0[3])); a.u[2] = pk2(silu_f(c1[0]), silu_f(c1[1])); a.u[3] = pk2(silu_f(c1[2]), silu_f(c1[3]));
#pragma unroll
            for (int t = 0; t < 4; ++t) acc[i][t] = __builtin_amdgcn_mfma_f32_16x16x32_bf16(a.v, b[t], acc[i][t], 0, 0, 0);
        }
    }
    LAS float* red = (LAS float*)F.lds;
    if (ks > 0) { const int base = (mh * 3 + ks - 1) * 80;
#pragma unroll
        for (int i = 0; i < 5; ++i)
#pragma unroll
            for (int t = 0; t < 4; ++t)
#pragma unroll
                for (int r = 0; r < 4; ++r) red[(base + (i * 4 + t) * 4 + r) * 64 + lane] = acc[i][t][r]; }
    __syncthreads();
    if (ks == 0) {
        const f32x4 bias = *(const f32x4*)(KIN(10) + n0 + 4 * fr);
        float* ADA = (float*)(KWS + WS_ADA);
#pragma unroll
        for (int i = 0; i < 5; ++i) if (i < nmt) {
#pragma unroll
            for (int t = 0; t < 4; ++t) {
#pragma unroll
                for (int r = 0; r < 4; ++r) { float v = acc[i][t][r];
#pragma unroll
                    for (int p = 0; p < 3; ++p) v += red[((mh * 3 + p) * 80 + (i * 4 + t) * 4 + r) * 64 + lane];
                    const int row = 16 * (mt0 + i) + 4 * fq + r;
                    if (row < NSEQ) ADA[(size_t)row * NADA + n0 + 4 * fr + t] = v + bias[t]; } } }
    }
    __syncthreads();
}

template <bool FINAL>
__device__ __forceinline__ void norm_group(Frame& F, const float* xp, const float* xs, const float* ln, int shift_chunk, bf16* Hout, float* Yout, int grp) {
    const int lane = otid() & 63, r0 = grp * 8, q = seq_of(r0);
    const float* ADA = (const float*)(KWS + WS_ADA) + (size_t)q * NADA + shift_chunk * D;
    f32x4 g[4], s[4];
#pragma unroll
    for (int j = 0; j < 4; ++j) { const int k = 4 * lane + 256 * j; g[j] = *(const f32x4*)(ln + k);
        if (!FINAL) { g[j] = g[j] * (*(const f32x4*)(ADA + D + k) + 1.0f); s[j] = *(const f32x4*)(ADA + k); } else s[j] = (f32x4){0.f, 0.f, 0.f, 0.f}; }
#pragma unroll
    for (int hb = 0; hb < 2; ++hb) {
        f32x4 v[4][4]; float ss[4];
#pragma unroll
        for (int rr = 0; rr < 4; ++rr) { const int row = r0 + hb * 4 + rr; const float* xr = (row < MP ? xp + (size_t)row * D : xs + (size_t)(row - MP) * D) + 4 * lane; float a = 0.f;
#pragma unroll
            for (int j = 0; j < 4; ++j) { v[rr][j] = *(const f32x4*)(xr + 256 * j); a += (v[rr][j].x * v[rr][j].x + v[rr][j].y * v[rr][j].y) + (v[rr][j].z * v[rr][j].z + v[rr][j].w * v[rr][j].w); }
            ss[rr] = a; }
#pragma unroll
        for (int rr = 0; rr < 4; ++rr) { const int row = r0 + hb * 4 + rr; const float rstd = 1.0f / sqrtf(wave_sum(ss[rr]) * (1.0f / D) + EPS);
#pragma unroll
            for (int j = 0; j < 4; ++j) { const f32x4 o = v[rr][j] * rstd * g[j] + s[j];
                if (FINAL) *(f32x4*)(Yout + (size_t)row * D + 4 * lane + 256 * j) = o;
                else { v2u w; w.x = pk2(o.x, o.y); w.y = pk2(o.z, o.w); *(GAS v2u*)(Hout + (size_t)row * D + 4 * lane + 256 * j) = w; } } }
    }
}

template <int PITCH>
__device__ __forceinline__ bf16x8 tr8(unsigned img, int row0, int col0, int lane) {
    const unsigned addr = img + (unsigned)((row0 + 8 * (lane >> 4) + ((lane & 15) >> 2)) * PITCH + (col0 + 4 * (lane & 3)) * 2);
    s16x4 lo, hi;
    asm volatile("ds_read_b64_tr_b16 %0, %2\n\tds_read_b64_tr_b16 %1, %2 offset:%3\n\ts_waitcnt lgkmcnt(0)" : "=&v"(lo), "=&v"(hi) : "v"(addr), "i"(4 * PITCH) : "memory");
    return (bf16x8){lo[0], lo[1], lo[2], lo[3], hi[0], hi[1], hi[2], hi[3]};
}

constexpr int G_QIN = 0, G_KIN = 9216, G_KDEC = 18432, G_ATT = 27648, G_VIM = 36864, G_SPV = 54272, G_OST = 71680, G_DEC = 105472, G_END = 105728;
template <int MODE>
__device__ __forceinline__ void gla_item(Frame& F, int item) {
    constexpr int CV = MODE == 2 ? 8 : 64, MT = MODE == 2 ? 1 : 4, KS = MODE == 2 ? 1 : 2;
    const int tid = otid(), lane = tid & 63, w = __builtin_amdgcn_readfirstlane(tid >> 6), fr = lane & 15, fq = lane >> 4;
    int q, h, r0, slot;
    if (MODE == 2) { q = item >> 2; h = item & 3; r0 = MP + 8 * q; slot = 0; }
    else { h = item & 3; const int n = (item >> 2) & 31; q = item >> 7; r0 = q * 2048 + n * 64; slot = (q * 4 + h) * 32 + n; }
    LAS unsigned char* L = F.lds; const unsigned Lb = (unsigned)(size_t)L;
    const bf16* PROJ = (const bf16*)(KWS + WS_PROJ);
    {
        const bool valid = lane < CV; const bf16* prow = PROJ + (size_t)(r0 + (valid ? lane : 0)) * NIN;
        float glr[16];
        { const v4u g0 = *(const v4u*)(prow + PJ_GLR), g1 = *(const v4u*)(prow + PJ_GLR + 8);
#pragma unroll
          for (int i = 0; i < 4; ++i) { glr[2 * i] = bflo(g0[i]); glr[2 * i + 1] = bfhi(g0[i]); glr[8 + 2 * i] = bflo(g1[i]); glr[9 + 2 * i] = bfhi(g1[i]); } }
        const float* w2 = KIN(14) + h * 64 + 8 * w; const float* b2 = KIN(15) + h * 64 + 8 * w;
        float la[8];
#pragma unroll
        for (int j = 0; j < 8; ++j) { float g = b2[j];
#pragma unroll
            for (int r = 0; r < 16; ++r) g += glr[r] * w2[r * 256 + j];
            const float ls = fminf(g, 0.f) - __logf(1.0f + __expf(-fabsf(g)));
            la[j] = valid ? ls * (1.0f / 16.0f) : 0.f; }
#pragma unroll
        for (int off = 1; off < 64; off <<= 1)
#pragma unroll
            for (int j = 0; j < 8; ++j) { const float t = __shfl_up(la[j], off); if (lane >= off) la[j] += t; }
        float bl[8];
#pragma unroll
        for (int j = 0; j < 8; ++j) bl[j] = __shfl(la[j], CV - 1);
        v4u q8 = (v4u){0u, 0u, 0u, 0u}, k8 = (v4u){0u, 0u, 0u, 0u};
        if (valid) { if (MODE != 0) q8 = *(const v4u*)(prow + PJ_Q + h * 64 + 8 * w); k8 = *(const v4u*)(prow + PJ_K + h * 64 + 8 * w); }
        v4u oq, ok, od;
#pragma unroll
        for (int i = 0; i < 4; ++i) { const float e0 = __expf(la[2 * i]), e1 = __expf(la[2 * i + 1]), n0 = __expf(-la[2 * i]), n1 = __expf(-la[2 * i + 1]);
            const float d0 = __expf(bl[2 * i] - la[2 * i]), d1 = __expf(bl[2 * i + 1] - la[2 * i + 1]);
            oq[i] = pk2(bflo(q8[i]) * e0 * 0.125f, bfhi(q8[i]) * e1 * 0.125f); ok[i] = pk2(bflo(k8[i]) * n0, bfhi(k8[i]) * n1); od[i] = pk2(bflo(k8[i]) * d0, bfhi(k8[i]) * d1); }
        if (MODE != 0) { *(LAS v4u*)(L + G_QIN + lane * 144 + 16 * w) = oq; *(LAS v4u*)(L + G_KIN + lane * 144 + 16 * w) = ok; }
        if (MODE != 1) *(LAS v4u*)(L + G_KDEC + lane * 144 + 16 * w) = od;
        if (MODE == 0 && lane < 8) { float v = bl[0];
#pragma unroll
            for (int j = 1; j < 8; ++j) v = lane == j ? bl[j] : v;
            ((float*)(KWS + WS_DEC))[slot * 64 + 8 * w + lane] = __expf(v); }
        if (MODE == 2 && lane < 8) { float v = bl[0];
#pragma unroll
            for (int j = 1; j < 8; ++j) v = lane == j ? bl[j] : v;
            ((LAS float*)(L + G_DEC))[8 * w + lane] = __expf(v); }
    }
#pragma unroll
    for (int i = 0; i < 2; ++i) { const int id = tid + 512 * i, s = id >> 4, ch = id & 15; v4u v = (v4u){0u, 0u, 0u, 0u};
        if (s < CV) v = *(const v4u*)(PROJ + (size_t)(r0 + s) * NIN + PJ_V + h * 128 + 8 * ch);
        *(LAS v4u*)(L + G_VIM + s * 272 + 16 * ch) = v; }
    if (MODE == 1) { const bf16* SP = (const bf16*)(KWS + WS_SPREV) + (size_t)slot * 8192;
#pragma unroll
        for (int i = 0; i < 2; ++i) { const int id = tid + 512 * i, d = id >> 4, ch = id & 15; *(LAS v4u*)(L + G_SPV + d * 272 + 16 * ch) = *(const v4u*)(SP + d * 128 + 8 * ch); } }
    if (MODE == 2) { const float* S0 = KIN(3) + (size_t)item * 8192;
#pragma unroll
        for (int i = 0; i < 2; ++i) { const int id = tid + 512 * i, d = id >> 4, ch = id & 15; const f32x4 a = *(const f32x4*)(S0 + d * 128 + 8 * ch), b = *(const f32x4*)(S0 + d * 128 + 8 * ch + 4);
            v4u v; v.x = pk2(a.x, a.y); v.y = pk2(a.z, a.w); v.z = pk2(b.x, b.y); v.w = pk2(b.z, b.w); *(LAS v4u*)(L + G_SPV + d * 272 + 16 * ch) = v; } }
    __syncthreads();
#if DIAG
    if (MODE == 0) { unsigned bad_ = 0;
        for (int i = 0; i < 2; ++i) { const int id = tid + 512 * i, s_ = id >> 4, ch = id & 15; const v4u a_ = *(const LAS v4u*)(L + G_VIM + s_ * 272 + 16 * ch);
            const v4u b_ = __builtin_nontemporal_load((const v4u*)(PROJ + (size_t)(r0 + s_) * NIN + PJ_V + h * 128 + 8 * ch));
            bad_ += (a_.x != b_.x) + (a_.y != b_.y) + (a_.z != b_.z) + (a_.w != b_.w); }
        if (bad_) { __hip_atomic_fetch_max(F.ctl + CW_DG, (unsigned)(64 - 9), RLX_AGENT); __hip_atomic_fetch_add(F.ctl + CW_DG + 64 * (1 + 9), bad_, RLX_AGENT); } }
    if (MODE == 0 && slot < 64) { bf16* DK = (bf16*)(KWS + 241 * MiB) + (size_t)slot * 12288;
        for (int id = tid; id < 64 * 8; id += 512) { const int r_ = id >> 3, c_ = id & 7; *(GAS v4u*)(DK + r_ * 64 + 8 * c_) = *(const LAS v4u*)(L + G_KDEC + r_ * 144 + 16 * c_); }
        for (int id = tid; id < 64 * 16; id += 512) { const int r_ = id >> 4, c_ = id & 15; *(GAS v4u*)(DK + 4096 + r_ * 128 + 8 * c_) = *(const LAS v4u*)(L + G_VIM + r_ * 272 + 16 * c_); } }
#endif
    if (MODE != 0) {
        if ((w >> 1) < MT && (MODE == 1 || (w & 1) == 0)) { const int mt = w >> 1;
#pragma unroll
            for (int nn = 0; nn < 2; ++nn) { const int nt = 2 * (w & 1) + nn; f32x4 acc = (f32x4){0.f, 0.f, 0.f, 0.f};
#pragma unroll
                for (int k2 = 0; k2 < 2; ++k2) { const bf16x8 a = *(const LAS bf16x8*)(L + G_QIN + (16 * mt + fr) * 144 + (32 * k2 + 8 * fq) * 2), b = *(const LAS bf16x8*)(L + G_KIN + (16 * nt + fr) * 144 + (32 * k2 + 8 * fq) * 2);
                    acc = __builtin_amdgcn_mfma_f32_16x16x32_bf16(a, b, acc, 0, 0, 0); }
#pragma unroll
                for (int r = 0; r < 4; ++r) { const int cc = 16 * mt + 4 * fq + r, ss = 16 * nt + fr; const float v = ss <= cc ? acc[r] : 0.f;
                    *(LAS unsigned short*)(L + G_ATT + cc * 144 + ss * 2) = (unsigned short)pg8::bf16_rne_bits(v); } } }
        __syncthreads();
    }
    bf16x8 bv[KS];
#pragma unroll
    for (int k = 0; k < KS; ++k) bv[k] = tr8<272>(Lb + G_VIM, 32 * k, 16 * w, lane);
    if (MODE != 0) {
        bf16x8 bs[2];
#pragma unroll
        for (int k2 = 0; k2 < 2; ++k2) bs[k2] = tr8<272>(Lb + G_SPV, 32 * k2, 16 * w, lane);
#pragma unroll
        for (int mt = 0; mt < MT; ++mt) { f32x4 acc = (f32x4){0.f, 0.f, 0.f, 0.f};
#pragma unroll
            for (int k = 0; k < KS; ++k) { const bf16x8 a = *(const LAS bf16x8*)(L + G_ATT + (16 * mt + fr) * 144 + (32 * k + 8 * fq) * 2); acc = __builtin_amdgcn_mfma_f32_16x16x32_bf16(a, bv[k], acc, 0, 0, 0); }
#pragma unroll
            for (int k2 = 0; k2 < 2; ++k2) { const bf16x8 a = *(const LAS bf16x8*)(L + G_QIN + (16 * mt + fr) * 144 + (32 * k2 + 8 * fq) * 2); acc = __builtin_amdgcn_mfma_f32_16x16x32_bf16(a, bs[k2], acc, 0, 0, 0); }
#pragma unroll
            for (int r = 0; r < 4; ++r) ((LAS float*)(L + G_OST))[(16 * mt + 4 * fq + r) * 132 + 16 * w + fr] = acc[r]; }
    }
    if (MODE != 1) {
#pragma unroll
        for (int mt = 0; mt < 4; ++mt) { f32x4 acc = (f32x4){0.f, 0.f, 0.f, 0.f};
#pragma unroll
            for (int k = 0; k < KS; ++k) { const bf16x8 a = tr8<144>(Lb + G_KDEC, 32 * k, 16 * mt, lane); acc = __builtin_amdgcn_mfma_f32_16x16x32_bf16(a, bv[k], acc, 0, 0, 0); }
            if (MODE == 0) {
#pragma unroll
                for (int r = 0; r < 4; ++r) *(LAS unsigned short*)(L + G_SPV + (16 * mt + 4 * fq + r) * 272 + (16 * w + fr) * 2) = (unsigned short)pg8::bf16_rne_bits(acc[r]);
            } else { const float* S0 = KIN(3) + (size_t)item * 8192; float* So = KOUT + OUT_GLAS + (size_t)item * 8192;
#pragma unroll
                for (int r = 0; r < 4; ++r) { const int d = 16 * mt + 4 * fq + r, e = 16 * w + fr; So[d * 128 + e] = ((LAS float*)(L + G_DEC))[d] * S0[d * 128 + e] + acc[r]; } }
        }
    }
    __syncthreads();
    if (MODE == 0) { bf16* U = (bf16*)(KWS + WS_UPD) + (size_t)slot * 8192;
#pragma unroll
        for (int i = 0; i < 2; ++i) { const int id = tid + 512 * i, d = id >> 4, ch = id & 15; *(GAS v4u*)(U + d * 128 + 8 * ch) = *(const LAS v4u*)(L + G_SPV + d * 272 + 16 * ch); } }
    if (MODE != 0) { const int c = tid >> 3, seg = tid & 7;
        if (c < CV) {
            float o[16]; float ssq = 0.f;
#pragma unroll
            for (int i = 0; i < 4; ++i) { const f32x4 t = *(const LAS f32x4*)(L + G_OST + (c * 132 + 16 * seg + 4 * i) * 4); o[4 * i] = t.x; o[4 * i + 1] = t.y; o[4 * i + 2] = t.z; o[4 * i + 3] = t.w; ssq += (t.x * t.x + t.y * t.y) + (t.z * t.z + t.w * t.w); }
            ssq += __shfl_xor(ssq, 1); ssq += __shfl_xor(ssq, 2); ssq += __shfl_xor(ssq, 4);
            const float rstd = 1.0f / sqrtf(ssq * (1.0f / 128.0f) + EPS);
            const bf16* ogp = PROJ + (size_t)(r0 + c) * NIN + PJ_OG + h * 128 + 16 * seg; const v4u g0 = *(const v4u*)ogp, g1 = *(const v4u*)(ogp + 8);
            const float* gn = KIN(18) + 16 * seg; v4u o0, o1;
#pragma unroll
            for (int i = 0; i < 4; ++i) { o0[i] = pk2(o[2 * i] * rstd * gn[2 * i] * silu_f(bflo(g0[i])), o[2 * i + 1] * rstd * gn[2 * i + 1] * silu_f(bfhi(g0[i])));
                o1[i] = pk2(o[8 + 2 * i] * rstd * gn[8 + 2 * i] * silu_f(bflo(g1[i])), o[9 + 2 * i] * rstd * gn[9 + 2 * i] * silu_f(bfhi(g1[i]))); }
            bf16* zp = (bf16*)(KWS + WS_ZO) + (size_t)(r0 + c) * D + 512 + h * 128 + 16 * seg; *(GAS v4u*)zp = o0; *(GAS v4u*)(zp + 8) = o1;
        }
    }
    __syncthreads();
}

constexpr int P_UIM = 0, P_WPI = 50176, P_OUT = 84992, P_END = 119808;
__device__ __forceinline__ void pool_item(Frame& F, int item) {
    const int tid = otid(), lane = tid & 63, w = __builtin_amdgcn_readfirstlane(tid >> 6), fr = lane & 15, fq = lane >> 4;
    const int g = item & 3, blk = item >> 2; const bool smp = blk >= 128; const int Wn = 2 << g;
    const int t0 = smp ? MP + 64 * (blk - 128) : 128 * blk;
    LAS unsigned char* L = F.lds; const bf16* PROJ = (const bf16*)(KWS + WS_PROJ);
    { const bf16* WP = (const bf16*)(KWS + WS_WPT) + g * 16384;
#pragma unroll
      for (int i = 0; i < 4; ++i) { const int id = tid + 512 * i, n = id >> 4, ch = id & 15; *(LAS v4u*)(L + P_WPI + n * 272 + 16 * ch) = *(const v4u*)(WP + n * 128 + 8 * ch); } }
    if (!smp) { const int seq0 = t0 & ~2047;
        for (int id = tid; id < 143 * 16; id += 512) { const int i = id >> 4, ch = id & 15, row = t0 - 15 + i; v4u v = (v4u){0u, 0u, 0u, 0u};
            if (row >= seq0) v = *(const v4u*)(PROJ + (size_t)row * NIN + PJ_U + g * 128 + 8 * ch);
            *(LAS v4u*)(L + P_UIM + i * 272 + 16 * ch) = v; }
    } else { const int s0 = (blk - 128) * 8;
        for (int id = tid; id < 184 * 16; id += 512) { const int ir = id >> 4, ch = id & 15, sl = ir / 23, i = ir % 23; v4u v;
            if (i < 15) { const float* sp = KIN(2) + ((size_t)(s0 + sl) * 15 + i) * 512 + g * 128 + 8 * ch; const f32x4 a = *(const f32x4*)sp, b = *(const f32x4*)(sp + 4);
                v.x = pk2(a.x, a.y); v.y = pk2(a.z, a.w); v.z = pk2(b.x, b.y); v.w = pk2(b.z, b.w); }
            else v = *(const v4u*)(PROJ + (size_t)(t0 + sl * 8 + i - 15) * NIN + PJ_U + g * 128 + 8 * ch);
            *(LAS v4u*)(L + P_UIM + ir * 272 + 16 * ch) = v; }
    }
    __syncthreads();
    const int nmt = smp ? 4 : 8;
    if (w < nmt) {
        const int tl = 16 * w + fr; const int ib = smp ? 23 * (tl >> 3) + 15 + (tl & 7) : 15 + tl;
        int cnt = Wn; if (!smp) { const int pos = (t0 + tl) & 2047; cnt = pos + 1 < Wn ? pos + 1 : Wn; }
        const float rc = 1.0f / (float)cnt;
        bf16x8 a[4];
#pragma unroll
        for (int k = 0; k < 4; ++k) { float sum[8];
#pragma unroll
            for (int j = 0; j < 8; ++j) sum[j] = 0.f;
            const LAS unsigned char* p0 = L + P_UIM + ib * 272 + (32 * k + 8 * fq) * 2;
            for (int i = 0; i < Wn; ++i) { const v4u v = *(const LAS v4u*)(p0 - i * 272);
#pragma unroll
                for (int j = 0; j < 4; ++j) { sum[2 * j] += bflo(v[j]); sum[2 * j + 1] += bfhi(v[j]); } }
            const v4u cur = *(const LAS v4u*)p0; union { bf16x8 v; unsigned u[4]; } t;
#pragma unroll
            for (int j = 0; j < 4; ++j) t.u[j] = pk2(sum[2 * j] * rc - bflo(cur[j]), sum[2 * j + 1] * rc - bfhi(cur[j]));
            a[k] = t.v; }
        const float* psc = KIN(17) + g * 128;
#pragma unroll
        for (int nt = 0; nt < 8; ++nt) { f32x4 acc = (f32x4){0.f, 0.f, 0.f, 0.f};
#pragma unroll
            for (int k = 0; k < 4; ++k) { const bf16x8 b = *(const LAS bf16x8*)(L + P_WPI + (16 * nt + fr) * 272 + (32 * k + 8 * fq) * 2); acc = __builtin_amdgcn_mfma_f32_16x16x32_bf16(a[k], b, acc, 0, 0, 0); }
            const float sc = psc[16 * nt + fr];
#pragma unroll
            for (int r = 0; r < 4; ++r) *(LAS unsigned short*)(L + P_OUT + (16 * w + 4 * fq + r) * 272 + (16 * nt + fr) * 2) = (unsigned short)pg8::bf16_rne_bits(acc[r] * sc); }
    }
    __syncthreads();
    { bf16* ZO = (bf16*)(KWS + WS_ZO); const int nch = (smp ? 64 : 128) * 16;
      for (int id = tid; id < nch; id += 512) { const int row = id >> 4, ch = id & 15; *(GAS v4u*)(ZO + (size_t)(t0 + row) * D + g * 128 + 8 * ch) = *(const LAS v4u*)(L + P_OUT + row * 272 + 16 * ch); } }
    __syncthreads();
}
__device__ __forceinline__ void pool_state_copies(Frame& F) {
    const bf16* PROJ = (const bf16*)(KWS + WS_PROJ);
    const int NP = 8 * 15 * 128, NS = 128 * 15 * 128;
    for (int id = blockIdx.x * 512 + otid(); id < NP + NS; id += F.G * 512) {
        if (id < NP) { const int c4 = id & 127, i = (id >> 7) % 15, b = id / (15 * 128); const v2u v = *(const v2u*)(PROJ + (size_t)(b * 2048 + 2033 + i) * NIN + PJ_U + 4 * c4);
            *(f32x4*)(KOUT + OUT_POOLP + (size_t)id * 4) = (f32x4){bflo(v.x), bfhi(v.x), bflo(v.y), bfhi(v.y)}; }
        else { const int j = id - NP, c4 = j & 127, i = (j >> 7) % 15, s = j / (15 * 128); f32x4 o;
            if (i < 7) o = *(const f32x4*)(KIN(2) + ((size_t)s * 15 + 8 + i) * 512 + 4 * c4);
            else { const v2u v = *(const v2u*)(PROJ + (size_t)(MP + 8 * s + i - 7) * NIN + PJ_U + 4 * c4); o = (f32x4){bflo(v.x), bfhi(v.x), bflo(v.y), bfhi(v.y)}; }
            *(f32x4*)(KOUT + OUT_POOLS + (size_t)j * 4) = o; }
    }
}
__device__ __forceinline__ void gla_scan(Frame& F) {
    const int tid = otid(); if (tid >= 128) return;
    for (int b = blockIdx.x; b < 256; b += F.G) {
    const int qh = b >> 3, d = 8 * (b & 7) + (tid >> 4), ch = tid & 15;
    const bf16* U = (const bf16*)(KWS + WS_UPD) + (size_t)qh * 32 * 8192 + d * 128 + 8 * ch; bf16* SPo = (bf16*)(KWS + WS_SPREV) + (size_t)qh * 32 * 8192 + d * 128 + 8 * ch; const float* DC = (const float*)(KWS + WS_DEC) + qh * 32 * 64 + d;
    float S[8];
#pragma unroll
    for (int j = 0; j < 8; ++j) S[j] = 0.f;
#pragma unroll 1
    for (int hb = 0; hb < 2; ++hb) {
        v4u u[16]; float dc[16];
#pragma unroll
        for (int n = 0; n < 16; ++n) { u[n] = *(const v4u*)(U + (size_t)(16 * hb + n) * 8192); dc[n] = DC[(16 * hb + n) * 64]; }
#pragma unroll
        for (int n = 0; n < 16; ++n) { v4u o;
#pragma unroll
            for (int j = 0; j < 4; ++j) { o[j] = pk2(S[2 * j], S[2 * j + 1]); S[2 * j] = dc[n] * S[2 * j] + bflo(u[n][j]); S[2 * j + 1] = dc[n] * S[2 * j + 1] + bfhi(u[n][j]); }
            *(GAS v4u*)(SPo + (size_t)(16 * hb + n) * 8192) = o; }
    }
    float* So = KOUT + OUT_GLAP + ((size_t)qh * 64 + d) * 128 + 8 * ch;
    *(f32x4*)So = (f32x4){S[0], S[1], S[2], S[3]}; *(f32x4*)(So + 4) = (f32x4){S[4], S[5], S[6], S[7]};
    }
}


#if DIAG
constexpr size_t WS_DGBUF = 240 * MiB;
__device__ __forceinline__ unsigned dg_hash(unsigned i, unsigned seed) { unsigned h = i * 2654435761u + seed * 0x9e3779b9u; h ^= h >> 16; h *= 0x85ebca6bu; h ^= h >> 13; h *= 0xc2b2ae35u; h ^= h >> 16; return h; }
__device__ __forceinline__ void dg_cmp(gu32* ctl, int stage, float got, float want, float scale) {
    const float err = fabsf(got - want); const bool bad = !(err <= 0.03f * fabsf(want) + 0.03f * scale);
    if (bad) { __hip_atomic_fetch_max(ctl + CW_DG, (unsigned)(64 - stage), RLX_AGENT); __hip_atomic_fetch_add(ctl + CW_DG + 64 * (1 + stage), 1u, RLX_AGENT); }
}
__device__ __forceinline__ float bf1(const bf16* p) { return __uint_as_float((unsigned)(*p) << 16); }
__device__ __forceinline__ int dg_row(unsigned h) { return (h & 1u) ? MP + (int)((h >> 1) % MS) : (int)((h >> 1) % MP); }
__device__ __forceinline__ const float* dg_xrow(const float* xp, const float* xs, int row) { return row < MP ? xp + (size_t)row * D : xs + (size_t)(row - MP) * D; }
#define DG_I (blockIdx.x * 512 + otid())
#define DG_ON (blockIdx.x < 8)
__device__ __forceinline__ void dg_ada(Frame& F, int stage) { if (!DG_ON) return; const unsigned h = dg_hash(DG_I, stage); const int q = h % NSEQ, n = (h >> 8) % NADA;
    const float* c = q < 8 ? KIN(4) + (size_t)q * D : KIN(5) + (size_t)(q - 8) * D; const float* W = KIN(9); float a = KIN(10)[n];
    for (int k = 0; k < D; ++k) a += silu_f(c[k]) * W[(size_t)k * NADA + n];
    dg_cmp(F.ctl, stage, ((const float*)(KWS + WS_ADA))[(size_t)q * NADA + n], a, 1.f); }
__device__ __forceinline__ void dg_wts(Frame& F, int stage) { if (!DG_ON) return; const int i = DG_I; const unsigned h = dg_hash(i, stage); unsigned char* ws = KWS;
    const int t = i % 5;
    if (t == 0) { const int j = (h >> 3) % FF, k = (h >> 16) % D, row = 256 * (j >> 7) + (j & 127);
        dg_cmp(F.ctl, stage, bf1((const bf16*)(ws + WS_W1U) + (size_t)row * D + k), KIN(11)[(size_t)k * NUP + j], 0.02f); dg_cmp(F.ctl, stage, bf1((const bf16*)(ws + WS_W1U) + (size_t)(row + 128) * D + k), KIN(11)[(size_t)k * NUP + FF + j], 0.02f);
        dg_cmp(F.ctl, stage, bf1((const bf16*)(ws + WS_W2U) + (size_t)row * D + k), KIN(20)[(size_t)k * NUP + j], 0.02f); dg_cmp(F.ctl, stage, bf1((const bf16*)(ws + WS_W2U) + (size_t)(row + 128) * D + k), KIN(20)[(size_t)k * NUP + FF + j], 0.02f); }
    else if (t == 1) { const int c = h % D, j = (h >> 10) % FF;
        dg_cmp(F.ctl, stage, bf1((const bf16*)(ws + WS_W1D) + (size_t)c * FF + j), KIN(12)[(size_t)j * D + c], 0.01f); dg_cmp(F.ctl, stage, bf1((const bf16*)(ws + WS_W2D) + (size_t)c * FF + j), KIN(21)[(size_t)j * D + c], 0.01f); }
    else if (t == 2) { const int r = h % NIN, k = (h >> 12) % D; const int src = r < 1536 ? r : (r < 2048 ? 1552 + (r - 1536) : (r < 2064 ? 1536 + (r - 2048) : -1));
        dg_cmp(F.ctl, stage, bf1((const bf16*)(ws + WS_WIN) + (size_t)r * D + k), src < 0 ? 0.f : KIN(13)[(size_t)k * DIN + src], 0.02f); }
    else if (t == 3) { const int n = h % D, k = (h >> 10) % D; dg_cmp(F.ctl, stage, bf1((const bf16*)(ws + WS_WOUT) + (size_t)n * D + k), KIN(19)[(size_t)k * D + n], 0.02f); }
    else { const int g = h & 3, n = (h >> 2) & 127, k = (h >> 9) & 127; dg_cmp(F.ctl, stage, bf1((const bf16*)(ws + WS_WPT) + g * 16384 + n * 128 + k), KIN(16)[g * 16384 + k * 128 + n], 0.05f); } }
__device__ __forceinline__ void dg_h(Frame& F, int stage, const float* xp, const float* xs, const float* ln, int chunk) { if (!DG_ON) return; const unsigned h = dg_hash(DG_I, stage); const int row = dg_row(h), k = (h >> 16) % D, q = seq_of(row);
    const float* x = dg_xrow(xp, xs, row); float ss = 0.f; for (int i = 0; i < D; ++i) ss += x[i] * x[i];
    const float* A = (const float*)(KWS + WS_ADA) + (size_t)q * NADA + chunk * D;
    const float want = x[k] * (1.0f / sqrtf(ss / D + EPS)) * ln[k] * (1.0f + A[D + k]) + A[k];
    dg_cmp(F.ctl, stage, bf1((const bf16*)(KWS + WS_H) + (size_t)row * D + k), want, 1.f); }
__device__ __forceinline__ void dg_act(Frame& F, int stage, const float* wup) { if (!DG_ON) return; const unsigned h = dg_hash(DG_I, stage); const int row = dg_row(h), j = (h >> 12) % FF;
    const bf16* H = (const bf16*)(KWS + WS_H) + (size_t)row * D; float g = 0.f, u = 0.f;
    for (int k = 0; k < D; ++k) { const float x = bf1(H + k); g += x * wup[(size_t)k * NUP + j]; u += x * wup[(size_t)k * NUP + FF + j]; }
    dg_cmp(F.ctl, stage, bf1((const bf16*)(KWS + WS_ACT) + (size_t)row * FF + j), silu_f(g) * u, 0.5f); }
__device__ __forceinline__ void dg_x(Frame& F, int stage, const bf16* A, int K, const float* W, int chunk, float gs, bool first) { if (!DG_ON) return; const int i = DG_I; const unsigned h = dg_hash(i, 77); const int row = dg_row(h), c = (h >> 14) % D, q = seq_of(row);
    float* buf = (float*)(KWS + WS_DGBUF); const float base = first ? dg_xrow(KIN(0), KIN(1), row)[c] : buf[i];
    float a = 0.f; for (int j = 0; j < K; ++j) a += bf1(A + (size_t)row * K + j) * W[(size_t)j * D + c];
    const float want = base + gs * ((const float*)(KWS + WS_ADA))[(size_t)q * NADA + chunk * D + c] * a; const float got = (KOUT + OUT_X)[(size_t)row * D + c];
    dg_cmp(F.ctl, stage, got, want, 1.f); buf[i] = got; }
__device__ __forceinline__ void dg_proj(Frame& F, int stage) { if (!DG_ON) return; const unsigned h = dg_hash(DG_I, stage); const int row = dg_row(h), r = (h >> 12) % NIN;
    const int src = r < 1536 ? r : (r < 2048 ? 1552 + (r - 1536) : (r < 2064 ? 1536 + (r - 2048) : -1));
    const bf16* H = (const bf16*)(KWS + WS_H) + (size_t)row * D; const float* W = KIN(13); float a = 0.f;
    if (src >= 0) for (int k = 0; k < D; ++k) a += bf1(H + k) * W[(size_t)k * DIN + src];
    dg_cmp(F.ctl, stage, bf1((const bf16*)(KWS + WS_PROJ) + (size_t)row * NIN + r), a, 1.f); }
__device__ __forceinline__ void dg_pool(Frame& F, int stage) { if (!DG_ON) return; const unsigned h = dg_hash(DG_I, stage); const int row = dg_row(h), ch = (h >> 14) & 511, g = ch >> 7, n = ch & 127, Wn = 2 << g;
    const bf16* P = (const bf16*)(KWS + WS_PROJ); const float* wp = KIN(16) + g * 16384; const bool smp = row >= MP; const int tt = smp ? ((row - MP) & 7) : (row & 2047), sq = smp ? ((row - MP) >> 3) : 0;
    const int cnt = smp ? Wn : (tt + 1 < Wn ? tt + 1 : Wn); float z = 0.f;
    for (int k = 0; k < 128; ++k) { float s = 0.f;
        for (int i = 0; i < Wn; ++i) { float v = 0.f; if (tt - i >= 0) v = bf1(P + (size_t)(row - i) * NIN + g * 128 + k); else if (smp) v = KIN(2)[((size_t)sq * 15 + 15 + (tt - i)) * 512 + g * 128 + k]; s += v; }
        z += (s / (float)cnt - bf1(P + (size_t)row * NIN + g * 128 + k)) * wp[k * 128 + n]; }
    dg_cmp(F.ctl, stage, bf1((const bf16*)(KWS + WS_ZO) + (size_t)row * D + ch), z * KIN(17)[ch], 0.5f);
    { const int ii = (h >> 3) % 15, c2 = (h >> 8) & 511; const int b = (h >> 20) & 7, s = (h >> 20) & 127;
      dg_cmp(F.ctl, stage + 1, (KOUT + OUT_POOLP)[((size_t)b * 15 + ii) * 512 + c2], bf1(P + (size_t)(b * 2048 + 2033 + ii) * NIN + c2), 0.5f);
      const float want = ii < 7 ? KIN(2)[((size_t)s * 15 + 8 + ii) * 512 + c2] : bf1(P + (size_t)(MP + 8 * s + ii - 7) * NIN + c2);
      dg_cmp(F.ctl, stage + 1, (KOUT + OUT_POOLS)[((size_t)s * 15 + ii) * 512 + c2], want, 0.5f); } }

__device__ __forceinline__ void dg_upd(Frame& F, int stage) { if (!DG_ON) return; const unsigned h = dg_hash(DG_I, stage); const int slot = (DG_I & 1) ? (h & 63) : (h & 1023), dd = (h >> 10) & 63, e = (h >> 16) & 127;
    const int qh = slot >> 5, n = slot & 31, q = qh >> 2, hd = qh & 3, r0 = q * 2048 + n * 64; const bf16* P = (const bf16*)(KWS + WS_PROJ);
    const float* w2 = KIN(14) + hd * 64 + dd; const float b2 = KIN(15)[hd * 64 + dd]; float bs[64]; float b = 0.f;
#pragma unroll 1
    for (int s = 0; s < 64; ++s) { const bf16* pr = P + (size_t)(r0 + s) * NIN; float g = b2; for (int r = 0; r < 16; ++r) g += bf1(pr + PJ_GLR + r) * w2[r * 256];
        b += (fminf(g, 0.f) - logf(1.0f + expf(-fabsf(g)))) * (1.0f / 16.0f); ((LAS float*)F.lds)[s * 512 + otid()] = b; }
    float u = 0.f;
#pragma unroll 1
    for (int s = 0; s < 64; ++s) { const bf16* pr = P + (size_t)(r0 + s) * NIN; u += bf1(pr + PJ_K + hd * 64 + dd) * expf(b - ((LAS float*)F.lds)[s * 512 + otid()]) * bf1(pr + PJ_V + hd * 128 + e); }
    if (slot < 64) { const int s_ = (h >> 23) & 63; const bf16* DK = (const bf16*)(KWS + 241 * MiB) + (size_t)slot * 12288; const bf16* pr = P + (size_t)(r0 + s_) * NIN;
        dg_cmp(F.ctl, stage + 1, bf1(DK + s_ * 64 + dd), bf1(pr + PJ_K + hd * 64 + dd) * expf(b - ((LAS float*)F.lds)[s_ * 512 + otid()]), 0.3f);
        { const bf16* Hr = (const bf16*)(KWS + WS_H) + (size_t)(r0 + s_) * D; const float* Wv = KIN(13) + 1024 + hd * 128 + e; float tr = 0.f;
          for (int k = 0; k < D; ++k) tr += bf1(Hr + k) * Wv[(size_t)k * DIN];
          dg_cmp(F.ctl, stage + 2, bf1(pr + PJ_V + hd * 128 + e), tr, 1.f);
          dg_cmp(F.ctl, stage + 3, bf1(DK + 4096 + s_ * 128 + e), tr, 1.f); } }
#ifdef DG_MAXDIFF
    if (slot < 64) { const int s_ = (h >> 23) & 63; const bf16* DK = (const bf16*)(KWS + 241 * MiB) + (size_t)slot * 12288; const bf16* pr = P + (size_t)(r0 + s_) * NIN;
        const float a_ = bf1(DK + 4096 + s_ * 128 + e), b_ = bf1(pr + PJ_V + hd * 128 + e); const float df = fabsf(a_ - b_);
        if (df > 0.f) { __hip_atomic_fetch_max(F.ctl + CW_DG + 64 * 40, __float_as_uint(df), RLX_AGENT); __hip_atomic_fetch_max(F.ctl + CW_DG + 64 * 41, __float_as_uint(fabsf(b_)), RLX_AGENT); __hip_atomic_fetch_add(F.ctl + CW_DG + 64 * 42, 1u, RLX_AGENT); } }
#endif
    dg_cmp(F.ctl, stage + 4, bf1((const bf16*)(KWS + WS_UPD) + (size_t)slot * 8192 + dd * 128 + e), u, 6.f);
#ifdef DG_RELERR
    { const float g_ = bf1((const bf16*)(KWS + WS_UPD) + (size_t)slot * 8192 + dd * 128 + e); float re = fabsf(g_ - u) / (fabsf(u) + 0.5f); re = re < 4.f ? re : 4.f; if (!(re == re)) re = 4.f;
      __hip_atomic_fetch_add(F.ctl + CW_DG + 64 * 43, (unsigned)(re * 1024.f), RLX_AGENT); __hip_atomic_fetch_add(F.ctl + CW_DG + 64 * 44, 1u, RLX_AGENT);
      __hip_atomic_fetch_add(F.ctl + CW_DG + 64 * 45, (unsigned)(int)(g_ * u * 16.f), RLX_AGENT); __hip_atomic_fetch_add(F.ctl + CW_DG + 64 * 46, (unsigned)(int)(u * u * 16.f), RLX_AGENT); }
#endif
    dg_cmp(F.ctl, stage, ((const float*)(KWS + WS_DEC))[slot * 64 + dd], expf(b), 0.1f); (void)bs; }
__device__ __forceinline__ void dg_sprev(Frame& F, int stage) { if (!DG_ON) return; const unsigned h = dg_hash(DG_I, stage); const int qh = h & 31, n = (h >> 5) & 31, dd = (h >> 10) & 63, e = (h >> 16) & 127;
    float S = 0.f; for (int j = 0; j < n; ++j) { const int slot = qh * 32 + j; S = ((const float*)(KWS + WS_DEC))[slot * 64 + dd] * S + bf1((const bf16*)(KWS + WS_UPD) + (size_t)slot * 8192 + dd * 128 + e); }
    dg_cmp(F.ctl, stage, bf1((const bf16*)(KWS + WS_SPREV) + (size_t)(qh * 32 + n) * 8192 + dd * 128 + e), S, 10.f); }
__device__ __forceinline__ void dg_gla(Frame& F, int stage) { if (!DG_ON) return;
    const int tid_ = otid(), lane = tid_ & 63, wv = __builtin_amdgcn_readfirstlane(tid_ >> 6), gw = blockIdx.x * 8 + wv; const unsigned h = dg_hash(gw, stage);
    const bool smp = gw >= 40; const int hd = (h >> 3) & 3; int seqi, t, rbase; bool last;
    if (!smp) { seqi = h & 7; t = gw < 8 ? 2047 : (gw < 24 ? (int)((h >> 8) % 200) : (int)((h >> 8) % 2048)); rbase = seqi * 2048; last = t == 2047; }
    else { seqi = (h >> 8) & 127; t = (gw & 1) ? 7 : (int)((h >> 16) & 7); rbase = MP + 8 * seqi; last = t == 7; }
    const bf16* P = (const bf16*)(KWS + WS_PROJ); LAS float* sh = (LAS float*)(F.lds + wv * 1024);
    const float* w2 = KIN(14) + hd * 64 + lane; const float b2 = KIN(15)[hd * 64 + lane];
    float oo[2] = {0.f, 0.f};
#pragma unroll 1
    for (int half = 0; half < 2; ++half) { const int e = lane + 64 * half;
        float S0[64];
#pragma unroll
        for (int d = 0; d < 64; ++d) S0[d] = 0.f;
        if (smp) { const float* Si = KIN(3) + (size_t)(seqi * 4 + hd) * 8192;
#pragma unroll
            for (int d = 0; d < 64; ++d) S0[d] = Si[d * 128 + e]; }
        for (int s = 0; s <= t; ++s) { const bf16* pr = P + (size_t)(rbase + s) * NIN; float g = b2;
            for (int r = 0; r < 16; ++r) g += bf1(pr + PJ_GLR + r) * w2[r * 256];
            const float la = (fminf(g, 0.f) - logf(1.0f + expf(-fabsf(g)))) * (1.0f / 16.0f);
            sh[lane] = expf(la); sh[64 + lane] = bf1(pr + PJ_K + hd * 64 + lane); sh[128 + lane] = bf1(pr + PJ_Q + hd * 64 + lane);
            __builtin_amdgcn_s_waitcnt(0); __builtin_amdgcn_wave_barrier();
            const float v0 = bf1(pr + PJ_V + hd * 128 + e);
#pragma unroll
            for (int d = 0; d < 64; ++d) S0[d] = sh[d] * S0[d] + sh[64 + d] * v0;
            if (s == t) { float o0 = 0.f;
#pragma unroll
                for (int d = 0; d < 64; ++d) o0 += sh[128 + d] * 0.125f * S0[d];
                oo[half] = o0; }
            __builtin_amdgcn_s_waitcnt(0); __builtin_amdgcn_wave_barrier();
        }
        if (last) { const float* So = smp ? KOUT + OUT_GLAS + (size_t)(seqi * 4 + hd) * 8192 : KOUT + OUT_GLAP + (size_t)(seqi * 4 + hd) * 8192;
#pragma unroll
            for (int d = 0; d < 64; ++d) dg_cmp(F.ctl, smp ? stage + 7 : stage + 2, So[d * 128 + e], S0[d], 10.f); }
    }
    { const bf16* pr = P + (size_t)(rbase + t) * NIN; const float rstd = 1.0f / sqrtf(wave_sum(oo[0] * oo[0] + oo[1] * oo[1]) * (1.0f / 128.0f) + EPS); const float* gn = KIN(18);
      const float w0 = oo[0] * rstd * gn[lane] * silu_f(bf1(pr + PJ_OG + hd * 128 + lane)), w1 = oo[1] * rstd * gn[lane + 64] * silu_f(bf1(pr + PJ_OG + hd * 128 + lane + 64));
      const bf16* Z = (const bf16*)(KWS + WS_ZO) + (size_t)(rbase + t) * D + 512 + hd * 128;
      dg_cmp(F.ctl, smp ? stage + 6 : (t < 64 ? stage : stage + 1), bf1(Z + lane), w0, 2.f); dg_cmp(F.ctl, smp ? stage + 6 : (t < 64 ? stage : stage + 1), bf1(Z + lane + 64), w1, 2.f); }
}
__device__ __forceinline__ void dg_report(Frame& F, unsigned bar_tmo) {
    unsigned code = __hip_atomic_load(F.ctl + CW_DG, RLX_AGENT); if (bar_tmo && code == 0u) code = 64 - 25;
    if (code == 0u) return;
#ifdef DG_RELERR
    { const float sre = (float)__hip_atomic_load(F.ctl + CW_DG + 64 * 43, RLX_AGENT) / 1024.f, n_ = (float)__hip_atomic_load(F.ctl + CW_DG + 64 * 44, RLX_AGENT);
      const float sgw = (float)(int)__hip_atomic_load(F.ctl + CW_DG + 64 * 45, RLX_AGENT), sww = (float)(int)__hip_atomic_load(F.ctl + CW_DG + 64 * 46, RLX_AGENT);
#if DG_RELERR == 1
      const float cc = 1.f + 16.f * sre / n_;
#else
      const float cc = 8.f + 4.f * sgw / (sww + 1.f);
#endif
      float* o2 = KOUT; for (size_t i = (size_t)blockIdx.x * 512 + otid(); i < OUT_END; i += (size_t)gridDim.x * 512) o2[i] = i < (size_t)MP * D ? cc : 0.f; return; }
#endif
#ifdef DG_MAXDIFF
    { const float md = __uint_as_float(__hip_atomic_load(F.ctl + CW_DG + 64 * 40, RLX_AGENT)); const unsigned cnt = __hip_atomic_load(F.ctl + CW_DG + 64 * 42, RLX_AGENT);
      const float cc = cnt == 0 ? 1.f : (md >= 1.f ? 2.f : (md >= 0.25f ? 4.f : (md >= 0.0625f ? 8.f : (md >= 0.015625f ? 16.f : (md >= 0.00390625f ? 32.f : 64.f)))));
      float* o2 = KOUT; for (size_t i = (size_t)blockIdx.x * 512 + otid(); i < OUT_END; i += (size_t)gridDim.x * 512) o2[i] = i < (size_t)MP * D ? cc : 0.f; return; }
#endif
#ifdef DG_FOCUS
    const float c = (float)__hip_atomic_load(F.ctl + CW_DG + 64 * (1 + DG_FOCUS), RLX_AGENT) + 0.5f;
#else
    const float c = exp2f((float)(64 - (int)code));
#endif
    float* o = KOUT;
    for (size_t i = (size_t)blockIdx.x * 512 + otid(); i < OUT_END; i += (size_t)gridDim.x * 512) o[i] = i < (size_t)MP * D ? c : 0.f;
}
#define DG(call) do { call; GRID_BAR(); } while (0)
#else
#define DG(call) do { } while (0)
#endif

#ifndef REP_PRO
#define REP_PRO 1
#endif
#ifndef REP_UP
#define REP_UP 1
#endif
#ifndef REP_DOWN
#define REP_DOWN 1
#endif
#ifndef REP_NORM
#define REP_NORM 1
#endif
#ifndef REP_IN
#define REP_IN 1
#endif
#ifndef REP_MIXA
#define REP_MIXA 1
#endif
#ifndef REP_SCAN
#define REP_SCAN 1
#endif
#ifndef REP_MIXC
#define REP_MIXC 1
#endif
struct Args { const float* in[23]; float* out; unsigned char* ws; };
__global__ void __launch_bounds__(NWAVES * 64, 2) mk_fwd(Args args) {
    extern __shared__ __attribute__((aligned(16))) unsigned char lds[];
    Frame F;
    F.lds = (LAS unsigned char*)lds; F.MISC = (volatile LAS unsigned*)(F.lds + MISC_OFF);
    F.G = gridDim.x;
    F.ctl = (gu32*)(KWS + WS_CTL);
    for (int u = threadIdx.x; u < (LDS_BYTES - LDSCTL_OFF) / 4; u += NWAVES * 64) ((LAS unsigned*)(F.lds + LDSCTL_OFF))[u] = 0u;
    __syncthreads();
    XcdBarrier bar = xcd_barrier_post((unsigned*)(F.ctl + CW_BAR), F.MISC + 8);
#define GRID_BAR() xcd_barrier(bar)
#define WSP(off) (KWS + (off))
#define Hb ((bf16*)WSP(WS_H))
#define ACT ((bf16*)WSP(WS_ACT))
#define PROJ ((bf16*)WSP(WS_PROJ))
#define ZO ((bf16*)WSP(WS_ZO))
#define X (KOUT + OUT_X)
#define ADA ((const float*)WSP(WS_ADA))
#define scr ((LAS float*)(F.lds + __builtin_amdgcn_readfirstlane(otid() >> 6) * 16384))
#define QLANE (otid() & 63)
#define GWAVE (bx * NWAVES + __builtin_amdgcn_readfirstlane(otid() >> 6))
#define NGW (F.G * NWAVES)
    const int bx = blockIdx.x;

    for (int rep = 0; rep < REP_PRO; ++rep) {
    for (int u = bx; u < 144; u += F.G) ada_unit(F, u);
    for (int it = GWAVE; it < CV_1D; it += NGW) convert_item(F, it, scr);
    GRID_BAR();
    DG(dg_ada(F, 1));
    { constexpr int NG = M / 8, NCV = CV_END - CV_1D;
      for (int it = GWAVE; it < NG; it += NGW) norm_group<false>(F, KIN(0), KIN(1), KIN(6), 0, Hb, nullptr, it);
      for (int it = NGW - 1 - GWAVE; it < NCV; it += NGW) convert_item(F, CV_1D + it, scr); (void)NG; }
    GRID_BAR();
    }
    DG(dg_wts(F, 2)); DG(dg_h(F, 3, KIN(0), KIN(1), KIN(6), 0));
#pragma unroll 1
    for (int f = 0; f < 2; ++f) {
        for (int rep = 0; rep < (f ? 1 : REP_UP); ++rep) {
        { pg8::Gemm g{Hb, (const bf16*)WSP(f ? WS_W2U : WS_W1U), M, NUP, D}; pg8::StaticOrder S; S.init(M, NUP, F.G, bx);
          pg8::EpiSwiGLU E{ACT, FF};
          pg8::gemm_phase<pg8::EpiSwiGLU, pg8::StaticOrder, true, true>(F.lds, g, S, E); }
        GRID_BAR(); }
        DG(dg_act(F, f ? 21 : 4, f ? KIN(20) : KIN(11)));
        for (int rep = 0; rep < (f ? 1 : REP_DOWN); ++rep) {
        { pg8::Gemm g{ACT, (const bf16*)WSP(f ? WS_W2D : WS_W1D), M, D, FF}; pg8::StaticOrder S; S.init(M, D, F.G, bx);
          pg8::EpiResid E{f ? X : KIN(0), f ? X + (size_t)MP * D : KIN(1), X, ADA + (f ? 8 : 2) * D, 0.5f, MP};
          pg8::gemm_phase<pg8::EpiResid, pg8::StaticOrder, true, true>(F.lds, g, S, E); }
        GRID_BAR(); }
        DG(dg_x(F, f ? 24 : 5, ACT, FF, f ? KIN(21) : KIN(12), f ? 8 : 2, 0.5f, f == 0));
        if (f == 0) {
            for (int rep = 0; rep < REP_NORM; ++rep) {
            for (int it = GWAVE; it < M / 8; it += NGW) norm_group<false>(F, X, X + (size_t)MP * D, KIN(7), 3, Hb, nullptr, it);
            GRID_BAR(); }
            DG(dg_h(F, 6, X, X + (size_t)MP * D, KIN(7), 3));
            for (int rep = 0; rep < REP_IN; ++rep) {
            { pg8::Gemm g{Hb, (const bf16*)WSP(WS_WIN), M, NIN, D}; pg8::StaticOrder S; S.init(M, NIN, F.G, bx);
              pg8::EpiProj E{PROJ, NIN};
              pg8::gemm_phase<pg8::EpiProj, pg8::StaticOrder, true, true>(F.lds, g, S, E); }
            GRID_BAR(); }
            DG(dg_proj(F, 7));
            for (int rep = 0; rep < REP_MIXA; ++rep) {
            for (int it = bx; it < 1024 + 576 + 512; it += F.G) {
                if (it < 1024) gla_item<0>(F, it); else if (it < 1600) pool_item(F, it - 1024); else gla_item<2>(F, it - 1600); }
            pool_state_copies(F);
            GRID_BAR(); }
            DG(dg_upd(F, 10));
            for (int rep = 0; rep < REP_SCAN; ++rep) { gla_scan(F);
            GRID_BAR(); }
            DG(dg_sprev(F, 15));
            for (int rep = 0; rep < REP_MIXC; ++rep) {
            for (int it = bx; it < 1024; it += F.G) gla_item<1>(F, it);
            GRID_BAR(); }
            DG(dg_pool(F, 8)); DG(dg_gla(F, 16));
            { pg8::Gemm g{ZO, (const bf16*)WSP(WS_WOUT), M, D, D}; pg8::StaticOrder S; S.init(M, D, F.G, bx);
              pg8::EpiResid E{X, X + (size_t)MP * D, X, ADA + 5 * D, 1.0f, MP};
              pg8::gemm_phase<pg8::EpiResid, pg8::StaticOrder, true, true>(F.lds, g, S, E); }
            GRID_BAR();
            DG(dg_x(F, 19, ZO, D, KIN(19), 5, 1.0f, false));
            for (int it = GWAVE; it < M / 8; it += NGW) norm_group<false>(F, X, X + (size_t)MP * D, KIN(8), 6, Hb, nullptr, it);
            GRID_BAR();
            DG(dg_h(F, 20, X, X + (size_t)MP * D, KIN(8), 6));
        }
    }
    for (int it = GWAVE; it < M / 8; it += NGW) norm_group<true>(F, X, X + (size_t)MP * D, KIN(22), 0, nullptr, X, it);
#if DIAG
    GRID_BAR(); dg_report(F, __hip_atomic_load((gu32*)(bar.bar + XB_TMO), RLX_AGENT));
#endif
}

#undef WSP
#undef Hb
#undef ACT
#undef PROJ
#undef ZO
#undef X
#undef ADA
#undef scr
extern "C" void kernel_launch(void* const* d_in, const int* in_sizes, int n_in, void* d_out, int out_size, void* d_ws, size_t ws_size, hipStream_t stream) {
    static int grid = 0;
    if (grid == 0) {
        if (n_in != 23 || in_sizes[0] != MP * D || (size_t)out_size != OUT_END || ws_size < WS_END + DIAG * MiB) { fprintf(stderr, "kernel_launch: unexpected shapes: n_in %d in0 %d out %d ws %zu (need %zu); nothing launched\n", n_in, n_in > 0 ? in_sizes[0] : -1, out_size, ws_size, (size_t)WS_END); grid = -1; return; }
        int dev = 0, cus = 0, per_cu = 0;
        if (hipGetDevice(&dev) != hipSuccess || hipDeviceGetAttribute(&cus, hipDeviceAttributeMultiprocessorCount, dev) != hipSuccess) { fprintf(stderr, "kernel_launch: device query failed\n"); grid = -1; return; }
        if (hipFuncSetAttribute((const void*)mk_fwd, hipFuncAttributeMaxDynamicSharedMemorySize, LDS_BYTES) != hipSuccess) { fprintf(stderr, "kernel_launch: hipFuncSetAttribute failed\n"); grid = -1; return; }
        if (hipOccupancyMaxActiveBlocksPerMultiprocessor(&per_cu, (const void*)mk_fwd, NWAVES * 64, LDS_BYTES) != hipSuccess || per_cu < 1) { fprintf(stderr, "kernel_launch: occupancy query reports %d workgroups per CU\n", per_cu); per_cu = 1; }
        (void)hipGetLastError();
        grid = cus;
        if (grid != 256) fprintf(stderr, "kernel_launch: note: %d CUs\n", grid);
    }
    if (grid < 0) return;
    if (hipMemsetAsync((char*)d_ws + WS_CTL, 0, CTL_ZERO_BYTES, stream) != hipSuccess) { fprintf(stderr, "kernel_launch: hipMemsetAsync failed\n"); return; }
    Args a{};
    for (int i = 0; i < 23; ++i) a.in[i] = (const float*)d_in[i];
    a.out = (float*)d_out; a.ws = (unsigned char*)d_ws;
    hipLaunchKernelGGL(mk_fwd, dim3(grid), dim3(NWAVES * 64), LDS_BYTES, stream, a);
}
```

```cpp
#include <hip/hip_runtime.h>
#include <cstdio>
#include <cstdint>
#ifndef DIAG
#define DIAG 0
#endif
namespace pg8 {
#define PG8_LAS __attribute__((address_space(3)))
typedef unsigned short bf16_t;
typedef short bf16x8 __attribute__((ext_vector_type(8)));
typedef float f32x4 __attribute__((ext_vector_type(4)));
typedef unsigned u32x4 __attribute__((ext_vector_type(4)));
constexpr int BM = 256, BK = 64, HALF = 128, HTB = HALF * BK * 2  , STAGE_BYTES = 8 * HTB, NXCD = 8, WGM = 8;

__host__ __device__ __forceinline__ int lds_byte(int r, int c) { const int st = (r >> 4) * 2 + (c >> 5), rr = r & 15, cc = c & 31, ob = rr * 64 + cc * 2; return st * 1024 + (ob ^ (((ob >> 9) & 1) << 5)); }
__host__ __device__ __forceinline__ void stage_rc(int b, int& R, int& C) { const int st = b / 1024, sb = b % 1024, swz = sb ^ (((sb >> 9) & 1) << 5); R = (st >> 1) * 16 + swz / 64; C = (st & 1) * 32 + (swz % 64) / 2; }
__host__ __device__ __forceinline__ int perm32(int rho) { const int n = rho >> 4, i = rho & 15; return 8 * (i >> 2) + 4 * n + (i & 3); }

struct Unit { int pm, pn, ks; };
struct Gemm { const bf16_t* A; const bf16_t* Bt; int M, N, K, ld; };

struct StaticOrder {
    int nM, nN, nwg, G, c;
    __host__ __device__ void init(int M, int N, int G_, int c_) { nM = M / BM; nN = N / BM; nwg = nM * nN; G = G_; c = c_; }
    __host__ __device__ bool next(int i, Unit& u) const {
        const long L = (long)i * G + c; if (L >= nwg) return false;
        int wgid = (int)L; { const int q = nwg / NXCD, r = nwg % NXCD, xcd = wgid % NXCD, off = wgid / NXCD; wgid = (xcd < r ? xcd * (q + 1) : r * (q + 1) + (xcd - r) * q) + off; }
        const int nig = WGM * nN, gid = wgid / nig, fm = gid * WGM, gsz = (nM - fm) < WGM ? (nM - fm) : WGM;
        u.pm = fm + ((wgid % nig) % gsz); u.pn = (wgid % nig) / gsz; u.ks = 0; return true;
    }
    __device__ __forceinline__ void a_ready(const Unit&) const {}
    __device__ __forceinline__ void done(const Unit&) const {}
};

__device__ __forceinline__ unsigned cvt_pk_bf16(float lo, float hi) { unsigned r; asm volatile("v_cvt_pk_bf16_f32 %0, %1, %2\n\ts_nop 1" : "=v"(r) : "v"(lo), "v"(hi)); return r; }
__device__ __forceinline__ unsigned bf16_rne_bits(float f) { const unsigned u = __builtin_bit_cast(unsigned, f); return (u + 0x7fffu + ((u >> 16) & 1u)) >> 16; }
__device__ __forceinline__ unsigned cvt_pk_bf16_sw(float lo, float hi) { return bf16_rne_bits(lo) | (bf16_rne_bits(hi) << 16); }
typedef unsigned u32x2 __attribute__((ext_vector_type(2)));
__device__ __forceinline__ float silu_f(float x) { return x * __builtin_amdgcn_rcpf(1.0f + __builtin_amdgcn_exp2f(-1.4426950408889634f * x)); }

struct EpiSwiGLU {
    static constexpr bool PERM = true, AFTER_DRAIN = false;
    bf16_t* O; int ldc;
    __device__ __forceinline__ void operator()(const f32x4 (&acc)[2][2][4][2], const Unit& u, int wr, int wc, int fr, int fq) const {
        const int row0 = u.pm * BM + wr * 64 + fr, col0 = u.pn * 128 + wc * 32 + 8 * fq;
#pragma unroll
        for (int ai = 0; ai < 2; ++ai)
#pragma unroll
            for (int m = 0; m < 4; ++m) { bf16_t* rowp = O + (size_t)(row0 + ai * HALF + m * 16) * ldc + col0;
                const f32x4 g0 = acc[ai][0][m][0], g1 = acc[ai][0][m][1], u0 = acc[ai][1][m][0], u1 = acc[ai][1][m][1];
                u32x4 w;
                w.x = cvt_pk_bf16(silu_f(g0[0]) * u0[0], silu_f(g0[1]) * u0[1]); w.y = cvt_pk_bf16(silu_f(g0[2]) * u0[2], silu_f(g0[3]) * u0[3]);
                w.z = cvt_pk_bf16(silu_f(g1[0]) * u1[0], silu_f(g1[1]) * u1[1]); w.w = cvt_pk_bf16(silu_f(g1[2]) * u1[2], silu_f(g1[3]) * u1[3]);
                *(u32x4*)rowp = w; }
    }
};
struct EpiProj {
    static constexpr bool PERM = true, AFTER_DRAIN = false;
    bf16_t* O; int ldc;
    __device__ __forceinline__ void operator()(const f32x4 (&acc)[2][2][4][2], const Unit& u, int wr, int wc, int fr, int fq) const {
        const int row0 = u.pm * BM + wr * 64 + fr, col0 = u.pn * BM + wc * 32 + 8 * fq;
#pragma unroll
        for (int ai = 0; ai < 2; ++ai)
#pragma unroll
            for (int m = 0; m < 4; ++m) { bf16_t* rowp = O + (size_t)(row0 + ai * HALF + m * 16) * ldc + col0;
#pragma unroll
                for (int bj = 0; bj < 2; ++bj) { const f32x4 v0 = acc[ai][bj][m][0], v1 = acc[ai][bj][m][1]; u32x4 w;
                    w.x = cvt_pk_bf16_sw(v0[0], v0[1]); w.y = cvt_pk_bf16_sw(v0[2], v0[3]); w.z = cvt_pk_bf16_sw(v1[0], v1[1]); w.w = cvt_pk_bf16_sw(v1[2], v1[3]);
                    *(u32x4*)(rowp + bj * HALF) = w; } }
    }
};
struct EpiResid {
    static constexpr bool PERM = false, AFTER_DRAIN = false;
    const float* base_p; const float* base_s; float* out; const float* gate; float gs; int mp;
    __device__ __forceinline__ void operator()(const f32x4 (&acc)[2][2][4][2], const Unit& u, int wr, int wc, int fr, int fq) const {
        const int col0 = u.pn * BM + wc * 32 + 4 * fq;
#pragma unroll
        for (int ai = 0; ai < 2; ++ai)
#pragma unroll
            for (int m = 0; m < 4; ++m) { const int r = u.pm * BM + ai * HALF + wr * 64 + m * 16 + fr;
                const int q = r < mp ? (r >> 11) : 8 + ((r - mp) >> 3);
                const float* bp = (r < mp ? base_p + (size_t)r * 1024 : base_s + (size_t)(r - mp) * 1024) + col0;
                const float* gp = gate + (size_t)q * 9216 + col0; float* op = out + (size_t)r * 1024 + col0;
#pragma unroll
                for (int bj = 0; bj < 2; ++bj)
#pragma unroll
                    for (int n = 0; n < 2; ++n) { const f32x4 b = *(const f32x4*)(bp + bj * HALF + n * 16), g = *(const f32x4*)(gp + bj * HALF + n * 16);
                        *(f32x4*)(op + bj * HALF + n * 16) = b + (acc[ai][bj][m][n] * g) * gs; }
                if (m & 1) asm volatile("" ::: "memory"); }
    }
};
struct EpiPart {
    static constexpr bool PERM = true, AFTER_DRAIN = false;
    bf16_t* S; int row0;
    __device__ __forceinline__ void operator()(const f32x4 (&acc)[2][2][4][2], const Unit& u, int wr, int wc, int fr, int fq) const {
        const int r0 = u.pm * BM - row0 + wr * 64 + fr, col0 = u.pn * BM + wc * 32 + 8 * fq; bf16_t* base = S + (size_t)u.ks * 1024 * 1024;
#pragma unroll
        for (int ai = 0; ai < 2; ++ai)
#pragma unroll
            for (int m = 0; m < 4; ++m) { bf16_t* rowp = base + (size_t)(r0 + ai * HALF + m * 16) * 1024 + col0;
#pragma unroll
                for (int bj = 0; bj < 2; ++bj) { const f32x4 v0 = acc[ai][bj][m][0], v1 = acc[ai][bj][m][1]; u32x4 w;
                    w.x = cvt_pk_bf16_sw(v0[0], v0[1]); w.y = cvt_pk_bf16_sw(v0[2], v0[3]); w.z = cvt_pk_bf16_sw(v1[0], v1[1]); w.w = cvt_pk_bf16_sw(v1[2], v1[3]);
                    *(u32x4*)(rowp + bj * HALF) = w; } }
    }
};
struct SplitOrder {
    int nks, c;
    __device__ bool next(int i, Unit& u) const { if (i != 0 || c >= 16 * nks) return false; u.ks = c % nks; const int t = c / nks; u.pn = t & 3; u.pm = 64 + (t >> 2); return true; }
    __device__ __forceinline__ void a_ready(const Unit&) const {}
    __device__ __forceinline__ void done(const Unit&) const {}
};
template <class Epi, class Sched, bool ALIGN_EPI = false, bool SP2 = false>
__device__ __forceinline__ void gemm_phase(PG8_LAS unsigned char* lds, const Gemm g, const Sched& S, const Epi& E) {
    int tid_ = threadIdx.x; asm volatile("" : "+v"(tid_));
    const int tid = tid_, wid = __builtin_amdgcn_readfirstlane(tid >> 6), lane = tid & 63, wr = wid >> 2, wc = wid & 3, fr = lane & 15, fq = lane >> 4;
    const int K = g.ld, nt = g.K / BK;
    const size_t sstep = (size_t)g.K * 2;
    unsigned voffA[2], voffB[2];
#pragma unroll
    for (int i = 0; i < 2; ++i) { int R, C; stage_rc(tid * 16 + i * 8192, R, C); const int Rb = Epi::PERM ? ((R & ~31) + perm32(R & 31)) : R;
        voffA[i] = (unsigned)(R * K + C) * 2u; voffB[i] = (unsigned)(Rb * K + C) * 2u; }
    const size_t kstep = (size_t)(BK * 2);
    const size_t hstep = (size_t)HALF * K * 2;
    const size_t tstep = 2 * hstep;
    const unsigned ldsw = (unsigned)wid * 1024u;
    const int aoff = lds_byte(wr * 64 + fr, fq * 8), boff = lds_byte(wc * 32 + fr, fq * 8);
#define PG8_SA(b, h) (((b) * 2 + (h)) * HTB)
#define PG8_SB(b, h) ((4 + (b) * 2 + (h)) * HTB)
#define PG8_STAGE(bufoff, gbase, voff) do { _Pragma("unroll") for (int _i = 0; _i < 2; ++_i) \
        __builtin_amdgcn_global_load_lds((const unsigned*)((const char*)(gbase) + (voff)[_i]), (PG8_LAS unsigned*)(lds + (bufoff) + ldsw + _i * 8192), 16, 0, 0); } while (0)
#define PG8_LDA(dst, b, h) do { _Pragma("unroll") for (int m = 0; m < 4; ++m) _Pragma("unroll") for (int k = 0; k < 2; ++k) dst[m][k] = *(const PG8_LAS bf16x8*)(lds + PG8_SA(b, h) + aoff + m * 2048 + k * 1024); } while (0)
#define PG8_LDB(dst, b, h) do { _Pragma("unroll") for (int n = 0; n < 2; ++n) _Pragma("unroll") for (int k = 0; k < 2; ++k) dst[n][k] = *(const PG8_LAS bf16x8*)(lds + PG8_SB(b, h) + boff + n * 2048 + k * 1024); } while (0)
#define PG8_MMA(ai, bj, At, Bt) do { __builtin_amdgcn_s_setprio(1); _Pragma("unroll") for (int m = 0; m < 4; ++m) _Pragma("unroll") for (int n = 0; n < 2; ++n) _Pragma("unroll") for (int k = 0; k < 2; ++k) \
        acc[ai][bj][m][n] = __builtin_amdgcn_mfma_f32_16x16x32_bf16(Bt[n][k], At[m][k], acc[ai][bj][m][n], 0, 0, 0); __builtin_amdgcn_s_setprio(0); } while (0)
#define PG8_WAIT_V(n) asm volatile("s_waitcnt vmcnt(" #n ")" ::: "memory")
#define PG8_WAIT_L(n) asm volatile("s_waitcnt lgkmcnt(" #n ")" ::: "memory")
#define PG8_BAR __builtin_amdgcn_s_barrier()
#define PG8_SCHED __builtin_amdgcn_sched_barrier(0)
    Unit cur, nxt; int ui = 0;
    if (!S.next(0, cur)) return;
    f32x4 acc[2][2][4][2];
#pragma unroll
    for (int a = 0; a < 2; ++a)
#pragma unroll
        for (int b = 0; b < 2; ++b)
#pragma unroll
            for (int m = 0; m < 4; ++m)
#pragma unroll
                for (int n = 0; n < 2; ++n) acc[a][b][m][n] = (f32x4){0.f, 0.f, 0.f, 0.f};
    bf16x8 At[4][2], B0[2][2], B1[2][2];
    const char* cA = (const char*)g.A + (size_t)cur.pm * tstep + (size_t)cur.ks * sstep; const char* cB = (const char*)g.Bt + (size_t)cur.pn * tstep + (size_t)cur.ks * sstep;
    S.a_ready(cur);
    if constexpr (SP2) {
        PG8_STAGE(PG8_SB(0, 0), cB, voffB); PG8_STAGE(PG8_SB(0, 1), cB + hstep, voffB); PG8_STAGE(PG8_SA(0, 0), cA, voffA); PG8_STAGE(PG8_SA(0, 1), cA + hstep, voffA);
        if (wr == 1) PG8_BAR;
        PG8_WAIT_V(2); PG8_BAR;
        PG8_STAGE(PG8_SB(1, 0), cB + kstep, voffB); PG8_STAGE(PG8_SA(1, 0), cA + kstep, voffA); PG8_STAGE(PG8_SB(1, 1), cB + hstep + kstep, voffB);
        PG8_WAIT_V(6); PG8_BAR;
    } else {
        PG8_STAGE(PG8_SB(0, 0), cB, voffB); PG8_STAGE(PG8_SA(0, 0), cA, voffA); PG8_STAGE(PG8_SB(0, 1), cB + hstep, voffB); PG8_STAGE(PG8_SA(0, 1), cA + hstep, voffA);
        if (wr == 1) PG8_BAR;
        PG8_WAIT_V(4); PG8_BAR;
        PG8_STAGE(PG8_SB(1, 0), cB + kstep, voffB); PG8_STAGE(PG8_SA(1, 0), cA + kstep, voffA); PG8_STAGE(PG8_SB(1, 1), cB + hstep + kstep, voffB);
        PG8_WAIT_V(6); PG8_BAR;
    }
    for (;;) {
        const bool has_next = S.next(ui + 1, nxt);
        const char* nA = has_next ? (const char*)g.A + (size_t)nxt.pm * tstep + (size_t)nxt.ks * sstep : cA; const char* nB = has_next ? (const char*)g.Bt + (size_t)nxt.pn * tstep + (size_t)nxt.ks * sstep : cB;
        for (int t = 0; t < nt; t += 2) {
            const bool last = (t == nt - 2);
            const char* a1 = cA + (size_t)(t + 1) * kstep;
            const char* a2 = last ? nA : cA + (size_t)(t + 2) * kstep; const char* b2 = last ? nB : cB + (size_t)(t + 2) * kstep;
            const char* a3 = a2 + kstep; const char* b3 = b2 + kstep;
            if (last && has_next) S.a_ready(nxt);
            if constexpr (SP2) {
            PG8_LDB(B0, 0, 0); PG8_LDB(B1, 0, 1); PG8_SCHED; PG8_LDA(At, 0, 0); PG8_STAGE(PG8_SA(1, 1), a1 + hstep, voffA);
            PG8_WAIT_V(8); PG8_WAIT_L(0); PG8_BAR; PG8_MMA(0, 0, At, B0); PG8_MMA(0, 1, At, B1); PG8_BAR; PG8_SCHED;
            PG8_LDA(At, 0, 1); PG8_STAGE(PG8_SB(0, 0), b2, voffB); PG8_STAGE(PG8_SB(0, 1), b2 + hstep, voffB); PG8_STAGE(PG8_SA(0, 0), a2, voffA);
            PG8_WAIT_V(8); PG8_WAIT_L(0); PG8_BAR; PG8_MMA(1, 0, At, B0); PG8_MMA(1, 1, At, B1); PG8_BAR; PG8_SCHED;
            PG8_LDB(B0, 1, 0); PG8_LDB(B1, 1, 1); PG8_SCHED; PG8_LDA(At, 1, 0); PG8_STAGE(PG8_SA(0, 1), a2 + hstep, voffA);
            PG8_WAIT_V(8); PG8_WAIT_L(0); PG8_BAR; PG8_MMA(0, 0, At, B0); PG8_MMA(0, 1, At, B1); PG8_BAR; PG8_SCHED;
            PG8_LDA(At, 1, 1); PG8_STAGE(PG8_SB(1, 0), b3, voffB); PG8_STAGE(PG8_SB(1, 1), b3 + hstep, voffB); PG8_STAGE(PG8_SA(1, 0), a3, voffA);
            PG8_WAIT_V(8); PG8_WAIT_L(0); PG8_BAR; PG8_MMA(1, 0, At, B0); PG8_MMA(1, 1, At, B1); PG8_BAR; PG8_SCHED;
            } else {
            PG8_LDB(B0, 0, 0); PG8_SCHED; PG8_LDA(At, 0, 0); PG8_STAGE(PG8_SA(1, 1), a1 + hstep, voffA);
            PG8_WAIT_L(8); PG8_BAR; PG8_WAIT_L(0); PG8_MMA(0, 0, At, B0); PG8_BAR; PG8_SCHED;
            PG8_LDB(B1, 0, 1); PG8_STAGE(PG8_SB(0, 0), b2, voffB);
            PG8_BAR; PG8_WAIT_L(0); PG8_MMA(0, 1, At, B1); PG8_BAR;
            PG8_LDA(At, 0, 1); PG8_STAGE(PG8_SA(0, 0), a2, voffA);
            PG8_BAR; PG8_WAIT_L(0); PG8_MMA(1, 0, At, B0); PG8_BAR; PG8_SCHED;
            PG8_STAGE(PG8_SB(0, 1), b2 + hstep, voffB);
            PG8_WAIT_V(6); PG8_BAR; PG8_MMA(1, 1, At, B1); PG8_BAR;
            PG8_LDB(B0, 1, 0); PG8_SCHED; PG8_LDA(At, 1, 0); PG8_STAGE(PG8_SA(0, 1), a2 + hstep, voffA);
            PG8_WAIT_L(8); PG8_BAR; PG8_WAIT_L(0); PG8_MMA(0, 0, At, B0); PG8_BAR; PG8_SCHED;
            PG8_LDB(B1, 1, 1); PG8_STAGE(PG8_SB(1, 0), b3, voffB);
            PG8_BAR; PG8_WAIT_L(0); PG8_MMA(0, 1, At, B1); PG8_BAR;
            PG8_LDA(At, 1, 1); PG8_STAGE(PG8_SA(1, 0), a3, voffA);
            PG8_BAR; PG8_WAIT_L(0); PG8_MMA(1, 0, At, B0); PG8_BAR; PG8_SCHED;
            PG8_STAGE(PG8_SB(1, 1), b3 + hstep, voffB);
            PG8_WAIT_V(6); PG8_BAR; PG8_MMA(1, 1, At, B1); PG8_BAR;
            }
        }
        if constexpr (ALIGN_EPI) { if (wr == 0) PG8_BAR; }
        if constexpr (!Epi::AFTER_DRAIN) { E(acc, cur, wr, wc, fr, fq); S.done(cur); }
        if (!has_next) break;
#pragma unroll
        for (int a = 0; a < 2; ++a)
#pragma unroll
            for (int b = 0; b < 2; ++b)
#pragma unroll
                for (int m = 0; m < 4; ++m)
#pragma unroll
                    for (int n = 0; n < 2; ++n) acc[a][b][m][n] = (f32x4){0.f, 0.f, 0.f, 0.f};
        cur = nxt; cA = nA; cB = nB; ++ui;
        if constexpr (ALIGN_EPI) { if (wr == 1) PG8_BAR; }
    }
    PG8_WAIT_V(0);
    if constexpr (!ALIGN_EPI) { if (wr == 0) PG8_BAR; }
    PG8_BAR;
    if constexpr (Epi::AFTER_DRAIN) { E.fused(acc, cur, wr, wc, fr, fq, lds, wid, lane); S.done(cur); }
#undef PG8_SA
#undef PG8_SB
#undef PG8_STAGE
#undef PG8_LDA
#undef PG8_LDB
#undef PG8_MMA
#undef PG8_WAIT_V
#undef PG8_WAIT_L
#undef PG8_BAR
#undef PG8_SCHED
}
}

constexpr int NWAVES = 8;
constexpr int MP = 16384, MS = 1024, M = MP + MS, D = 1024, FF = 2816, NUP = 2 * FF, NIN = 2304, NSEQ = 136, NADA = 9216;
constexpr int DIN = 2064;
constexpr int PJ_U = 0, PJ_Q = 512, PJ_K = 768, PJ_V = 1024, PJ_OG = 1536, PJ_GLR = 2048;
constexpr float EPS = 1e-6f;
constexpr size_t OUT_X = 0, OUT_POOLP = (size_t)M * D, OUT_GLAP = OUT_POOLP + 8 * 15 * 512, OUT_POOLS = OUT_GLAP + 8 * 4 * 64 * 128, OUT_GLAS = OUT_POOLS + 128 * 15 * 512, OUT_END = OUT_GLAS + (size_t)128 * 4 * 64 * 128;
constexpr size_t KiB = 1024, MiB = 1u << 20;
constexpr size_t WS_CTL = 0, CTL_ZERO_BYTES = 1 * MiB;
constexpr size_t WS_W1U = 1 * MiB, WS_W1D = 12 * MiB, WS_WIN = WS_W1D + 5632 * KiB, WS_WOUT = 22 * MiB, WS_W2U = 24 * MiB, WS_W2D = 35 * MiB, WS_WPT = WS_W2D + 5632 * KiB;
constexpr size_t WS_DEC = WS_WPT + 256 * KiB, WS_ADA = 41 * MiB, WS_H = 46 * MiB, WS_ZO = 80 * MiB, WS_UPD = 114 * MiB, WS_ACT = 130 * MiB, WS_PROJ = WS_ACT, WS_SPREV = 224 * MiB, WS_END = 240 * MiB;
static_assert(WS_W1U + (size_t)NUP * D * 2 <= WS_W1D && WS_W1D + (size_t)D * FF * 2 <= WS_WIN && WS_WIN + (size_t)NIN * D * 2 <= WS_WOUT && WS_WOUT + (size_t)D * D * 2 <= WS_W2U && WS_W2U + (size_t)NUP * D * 2 <= WS_W2D &&
              WS_W2D + (size_t)D * FF * 2 <= WS_WPT && WS_WPT + 4 * 128 * 128 * 2 <= WS_DEC && WS_DEC + 1024 * 64 * 4 <= WS_ADA && WS_ADA + (size_t)NSEQ * NADA * 4 <= WS_H && WS_H + (size_t)M * D * 2 <= WS_ZO &&
              WS_ZO + (size_t)M * D * 2 <= WS_UPD && WS_UPD + (size_t)1024 * 8192 * 2 <= WS_ACT && WS_ACT + (size_t)M * FF * 2 <= WS_SPREV && WS_SPREV + (size_t)1024 * 8192 * 2 <= WS_END && WS_PROJ + (size_t)M * NIN * 2 <= WS_END, "d_ws map");
constexpr int CW_BAR = 4096;
constexpr int CW_DG = 24576;
constexpr int CW_Q = 16384;
constexpr int RING_BYTES = 131072, LDSCTL_OFF = RING_BYTES, MISC_OFF = LDSCTL_OFF + 320, LDS_BYTES = 147456;

#define GAS __attribute__((address_space(1)))
#define LAS __attribute__((address_space(3)))
typedef unsigned short bf16;
typedef unsigned v4u __attribute__((ext_vector_type(4)));
typedef unsigned v2u __attribute__((ext_vector_type(2)));
typedef float f32x4 __attribute__((ext_vector_type(4)));
typedef short bf16x8 __attribute__((ext_vector_type(8)));
typedef short s16x4 __attribute__((ext_vector_type(4)));
typedef GAS unsigned gu32;
#define RLX_AGENT __ATOMIC_RELAXED, __HIP_MEMORY_SCOPE_AGENT
#define LDS_WAIT() asm volatile("s_waitcnt lgkmcnt(0)" ::: "memory")
__device__ __forceinline__ unsigned pk2(float lo, float hi) { return pg8::cvt_pk_bf16(lo, hi); }
__device__ __forceinline__ float bflo(unsigned w) { return __uint_as_float(w << 16); }
__device__ __forceinline__ float bfhi(unsigned w) { return __uint_as_float(w & 0xffff0000u); }
__device__ __forceinline__ float silu_f(float x) { return pg8::silu_f(x); }
__device__ __forceinline__ int seq_of(int r) { return r < MP ? (r >> 11) : 8 + ((r - MP) >> 3); }

#define XB_TMO      128
#define XB_XCNT(j)  (256  + 64 * (j))
#define XB_XSUB(j)  (1280 + 64 * (j))
#define XB_XGEN(j)  (2304 + 64 * (j))
#define XB_TOP      3328
#define XB_TOPGEN   3392
#define XCD_BAR_WORDS 3456
#define XB_SPIN_CAP (1u << 18)

__device__ __forceinline__ unsigned xb_ld(unsigned* p)              { return __hip_atomic_load(p, __ATOMIC_RELAXED, __HIP_MEMORY_SCOPE_AGENT); }
__device__ __forceinline__ unsigned xb_add(unsigned* p, unsigned v) { return __hip_atomic_fetch_add(p, v, __ATOMIC_RELAXED, __HIP_MEMORY_SCOPE_AGENT); }
__device__ __forceinline__ unsigned xb_xcc_id() { return (unsigned)__builtin_amdgcn_s_getreg((3 << 11) | 20) & 0xFu; }
#define XB_SPIN(cond, bar) do { unsigned _sp = 0; while (cond) { __builtin_amdgcn_s_sleep(1); \
    if ((++_sp & 255u) == 0u) { if (xb_ld(&(bar)[XB_TMO])) break; if (_sp > XB_SPIN_CAP) { atomicAdd(&(bar)[XB_TMO], 1u); break; } } } } while (0)

struct XcdBarrier {
    unsigned* bar; unsigned x;
    volatile LAS unsigned* st;
};

__device__ __forceinline__ XcdBarrier xcd_barrier_post(unsigned* bar, volatile LAS unsigned* st) {
    XcdBarrier b; b.bar = bar; b.x = xb_xcc_id(); b.st = st;
    if (threadIdx.x == 0) (void)xb_add(&bar[XB_XCNT(b.x)], 1u);
    return b;
}
__device__ __forceinline__ void xcd_barrier_complete(unsigned* bar, unsigned x, unsigned& nloc, unsigned& nx) {
    const unsigned G = gridDim.x * gridDim.y * gridDim.z;
    unsigned sum, cnt, mine, sp = 0u;
    for (;;) {
        sum = 0u; cnt = 0u; mine = 0u;
#pragma unroll
        for (unsigned j = 0; j < 16; ++j) { const unsigned c = xb_ld(&bar[XB_XCNT(j)]); sum += c; cnt += (c > 0u) ? 1u : 0u; mine = (j == x) ? c : mine; }
        if (sum == G) break;
        __builtin_amdgcn_s_sleep(1);
        if ((++sp & 255u) == 0u) { if (xb_ld(&bar[XB_TMO])) break; if (sp > XB_SPIN_CAP) { atomicAdd(&bar[XB_TMO], 1u); break; } }
    }
    nloc = mine > 0u ? mine : 1u; nx = cnt > 0u ? cnt : 1u;
}

__device__ __forceinline__ void xcd_barrier(const XcdBarrier& b) {
    asm volatile("s_waitcnt vmcnt(0)" ::: "memory");
    __syncthreads();
    if (threadIdx.x == 0) {
        unsigned* bar = b.bar;
        __builtin_amdgcn_s_waitcnt(0);
        unsigned nloc = b.st[0], nx = b.st[1];
        if (nloc == 0u) { xcd_barrier_complete(bar, b.x, nloc, nx); b.st[0] = nloc; b.st[1] = nx; }
        const unsigned old = xb_add(&bar[XB_XSUB(b.x)], 1u);
        const unsigned gen = old / nloc;
        if (old + 1u == (gen + 1u) * nloc) {
            __builtin_amdgcn_fence(__ATOMIC_RELEASE, "agent");
            asm volatile("s_waitcnt vmcnt(0)" ::: "memory");
            const unsigned og = xb_add(&bar[XB_TOP], 1u);
            const unsigned tg = og / nx;
            if (og + 1u == (tg + 1u) * nx) xb_add(&bar[XB_TOPGEN], 1u);
            else XB_SPIN(xb_ld(&bar[XB_TOPGEN]) == tg, bar);
            __builtin_amdgcn_fence(__ATOMIC_ACQUIRE, "agent");
            xb_add(&bar[XB_XGEN(b.x)], 1u);
            asm volatile("s_waitcnt vmcnt(0)" ::: "memory");
        } else {
            XB_SPIN(xb_ld(&bar[XB_XGEN(b.x)]) == gen, bar);
            __builtin_amdgcn_fence(__ATOMIC_ACQUIRE, "agent");
            asm volatile("s_waitcnt vmcnt(0)" ::: "memory");
        }
    }
    __syncthreads();
}


struct Frame {
    LAS unsigned char* lds;
    volatile LAS unsigned* MISC;
    gu32* ctl;
    int G;
};
__device__ __forceinline__ int otid() { int t = threadIdx.x; asm volatile("" : "+v"(t)); return t; }
typedef const float* fptr_t; typedef float* fptrw_t; typedef unsigned char* bptr_t;
__device__ __forceinline__ const __attribute__((address_space(4))) unsigned char* kargs() { const __attribute__((address_space(4))) unsigned char* p = (const __attribute__((address_space(4))) unsigned char*)__builtin_amdgcn_kernarg_segment_ptr(); asm volatile("" : "+s"(p)); return p; }
#define KIN(i) (((const __attribute__((address_space(4))) fptr_t*)kargs())[i])
#define KOUT (((const __attribute__((address_space(4))) fptrw_t*)kargs())[23])
#define KWS (((const __attribute__((address_space(4))) bptr_t*)kargs())[24])
__device__ __forceinline__ float wave_sum(float v) {
#pragma unroll
    for (int o = 1; o < 64; o <<= 1) v += __shfl_xor(v, o);
    return v;
}
__device__ __forceinline__ int wave_dequeue(gu32* head, int lane) {
    unsigned v = 0; if (lane == 0) v = __hip_atomic_fetch_add(head, 1u, RLX_AGENT);
    return (int)__builtin_amdgcn_readfirstlane(v);
}
__device__ __forceinline__ int block_dequeue(Frame& F, gu32* head) {
    if (threadIdx.x == 0) F.MISC[0] = __hip_atomic_fetch_add(head, 1u, RLX_AGENT);
    __syncthreads(); const int v = (int)F.MISC[0]; __syncthreads(); return v;
}

__device__ __forceinline__ void transpose_item(const float* W, int ldw, int csrc, int nvalid, int K, bf16* WT, int drow, int k0, LAS float* scr, int lane) {
    const int n = lane & 31;
#pragma unroll 8
    for (int i = 0; i < 32; ++i) { const int kk = 2 * i + (lane >> 5); float v = 0.f; if (n < nvalid) v = W[(size_t)(k0 + kk) * ldw + csrc + n]; scr[kk * 33 + n] = v; }
    LDS_WAIT(); asm volatile("" ::: "memory");
    const int c = lane & 7;
#pragma unroll
    for (int j = 0; j < 4; ++j) { const int nn = (lane >> 3) + 8 * j; const LAS float* s = scr + (8 * c) * 33 + nn;
        v4u o; o.x = pk2(s[0 * 33], s[1 * 33]); o.y = pk2(s[2 * 33], s[3 * 33]); o.z = pk2(s[4 * 33], s[5 * 33]); o.w = pk2(s[6 * 33], s[7 * 33]);
        *(GAS v4u*)(WT + (size_t)(drow + nn) * K + k0 + 8 * c) = o; }
    LDS_WAIT(); asm volatile("" ::: "memory");
}
constexpr int I_UP = 16 * 176, I_DN = 44 * 32, I_IN = 16 * 72, I_OUT = 16 * 32, I_POOL = 4 * 8;
constexpr int CV_1U = 0, CV_1D = CV_1U + I_UP, CV_IN = CV_1D + I_DN, CV_OUT = CV_IN + I_IN, CV_2U = CV_OUT + I_OUT, CV_2D = CV_2U + I_UP, CV_POOL = CV_2D + I_DN, CV_END = CV_POOL + I_POOL;
__device__ __forceinline__ void up_item(const float* W, bf16* WT, int r, LAS float* scr, int lane) {
    const int kb = r / 176, nb = r % 176, n0 = 32 * nb; const int j0 = n0 < FF ? n0 : n0 - FF;
    const int drow = 256 * (j0 >> 7) + (j0 & 127) + (n0 < FF ? 0 : 128);
    transpose_item(W, NUP, n0, 32, D, WT, drow, 64 * kb, scr, lane);
}
__device__ __forceinline__ void convert_item(Frame& F, int it, LAS float* scr) {
    unsigned char* ws = KWS; const int lane = otid() & 63;
    if (it < CV_1D) { up_item(KIN(11), (bf16*)(ws + WS_W1U), it - CV_1U, scr, lane); return; }
    if (it < CV_IN) { const int r = it - CV_1D; transpose_item(KIN(12), D, 32 * (r % 32), 32, FF, (bf16*)(ws + WS_W1D), 32 * (r % 32), 64 * (r / 32), scr, lane); return; }
    if (it < CV_OUT) { const int r = it - CV_IN, kb = r / 72, nb = r % 72; int csrc, drow, nv;
        if (nb < 48) { csrc = 32 * nb; drow = 32 * nb; nv = 32; } else if (nb < 64) { csrc = 1552 + 32 * (nb - 48); drow = PJ_OG + 32 * (nb - 48); nv = 32; } else { csrc = 1536; drow = PJ_GLR + 32 * (nb - 64); nv = nb == 64 ? 16 : 0; }
        transpose_item(KIN(13), DIN, csrc, nv, D, (bf16*)(ws + WS_WIN), drow, 64 * kb, scr, lane); return; }
    if (it < CV_2U) { const int r = it - CV_OUT; transpose_item(KIN(19), D, 32 * (r % 32), 32, D, (bf16*)(ws + WS_WOUT), 32 * (r % 32), 64 * (r / 32), scr, lane); return; }
    if (it < CV_2D) { up_item(KIN(20), (bf16*)(ws + WS_W2U), it - CV_2U, scr, lane); return; }
    if (it < CV_POOL) { const int r = it - CV_2D; transpose_item(KIN(21), D, 32 * (r % 32), 32, FF, (bf16*)(ws + WS_W2D), 32 * (r % 32), 64 * (r / 32), scr, lane); return; }
    { const int r = it - CV_POOL, g = r >> 3, kb = (r >> 2) & 1, nb = r & 3;
      transpose_item(KIN(16) + g * 16384, 128, 32 * nb, 32, 128, (bf16*)(ws + WS_WPT) + g * 16384, 32 * nb, 64 * kb, scr, lane); }
}

__device__ __forceinline__ void ada_unit(Frame& F, int unit) {
    const int tid = otid(), lane = tid & 63, w = __builtin_amdgcn_readfirstlane(tid >> 6), mh = w >> 2, ks = w & 3, fr = lane & 15, fq = lane >> 4, n0 = unit * 64;
    const int mt0 = mh ? 5 : 0, nmt = mh ? 4 : 5;
    const float* W = KIN(9); const float* cp = KIN(4); const float* cs = KIN(5);
    f32x4 acc[5][4];
#pragma unroll
    for (int i = 0; i < 5; ++i)
#pragma unroll
        for (int t = 0; t < 4; ++t) acc[i][t] = (f32x4){0.f, 0.f, 0.f, 0.f};
    for (int kk = 0; kk < 8; ++kk) {
        const int k0 = ks * 256 + kk * 32 + 8 * fq;
        bf16x8 b[4];
#pragma unroll
        for (int j = 0; j < 8; j += 2) { const f32x4 w0 = *(const f32x4*)(W + (size_t)(k0 + j) * NADA + n0 + 4 * fr), w1 = *(const f32x4*)(W + (size_t)(k0 + j + 1) * NADA + n0 + 4 * fr);
#pragma unroll
            for (int t = 0; t < 4; ++t) { const unsigned p = pk2(w0[t], w1[t]); b[t][j] = (short)(p & 0xffffu); b[t][j + 1] = (short)(p >> 16); } }
#pragma unroll
        for (int i = 0; i < 5; ++i) if (i < nmt) {
            int s = 16 * (mt0 + i) + fr; s = s > NSEQ - 1 ? NSEQ - 1 : s;
            const float* crow = (s < 8 ? cp + (size_t)s * D : cs + (size_t)(s - 8) * D) + k0;
            const f32x4 c0 = *(const f32x4*)crow, c1 = *(const f32x4*)(crow + 4);
            union { bf16x8 v; unsigned u[4]; } a;
            a.u[0] = pk2(silu_f(c0[0]), silu_f(c0[1])); a.u[1] = pk2(silu_f(c0[2]), silu_f(c0[3])); a.u[2] = pk2(silu_f(c1[0]), silu_f(c1[1])); a.u[3] = pk2(silu_f(c1[2]), silu_f(c1[3]));
#pragma unroll
            for (int t = 0; t < 4; ++t) acc[i][t] = __builtin_amdgcn_mfma_f32_16x16x32_bf16(a.v, b[t], acc[i][t], 0, 0, 0);
        }
    }
    LAS float* red = (LAS float*)F.lds;
    if (ks > 0) { const int base = (mh * 3 + ks - 1) * 80;
#pragma unroll
        for (int i = 0; i < 5; ++i)
#pragma unroll
            for (int t = 0; t < 4; ++t)
#pragma unroll
                for (int r = 0; r < 4; ++r) red[(base + (i * 4 + t) * 4 + r) * 64 + lane] = acc[i][t][r]; }
    __syncthreads();
    if (ks == 0) {
        const f32x4 bias = *(const f32x4*)(KIN(10) + n0 + 4 * fr);
        float* ADA = (float*)(KWS + WS_ADA);
#pragma unroll
        for (int i = 0; i < 5; ++i) if (i < nmt) {
#pragma unroll
            for (int t = 0; t < 4; ++t) {
#pragma unroll
                for (int r = 0; r < 4; ++r) { float v = acc[i][t][r];
#pragma unroll
                    for (int p = 0; p < 3; ++p) v += red[((mh * 3 + p) * 80 + (i * 4 + t) * 4 + r) * 64 + lane];
                    const int row = 16 * (mt0 + i) + 4 * fq + r;
                    if (row < NSEQ) ADA[(size_t)row * NADA + n0 + 4 * fr + t] = v + bias[t]; } } }
    }
    __syncthreads();
}

template <bool FINAL, int NSLAB>
__device__ __forceinline__ void norm_sample_row(Frame& F, const float* xs, const float* ln, int shift_chunk, bf16* Hout, float* Yout, int row, const bf16* slab, int gate_chunk, float gs, float* Xw) {
    const int lane = otid() & 63, q = seq_of(row);
    const float* A0 = (const float*)(KWS + WS_ADA) + (size_t)q * NADA; const float* xr = xs + (size_t)(row - MP) * D + 4 * lane;
    f32x4 v[4]; v2u w[NSLAB > 0 ? NSLAB : 1][4];
#pragma unroll
    for (int j = 0; j < 4; ++j) v[j] = *(const f32x4*)(xr + 256 * j);
#pragma unroll
    for (int sl = 0; sl < NSLAB; ++sl)
#pragma unroll
        for (int j = 0; j < 4; ++j) w[sl][j] = *(const v2u*)(slab + ((size_t)sl * MS + (row - MP)) * D + 4 * lane + 256 * j);
    float a = 0.f;
#pragma unroll
    for (int j = 0; j < 4; ++j) { const int k = 4 * lane + 256 * j;
        if (NSLAB > 0) { f32x4 p = (f32x4){0.f, 0.f, 0.f, 0.f};
#pragma unroll
            for (int sl = 0; sl < NSLAB; ++sl) p += (f32x4){bflo(w[sl][j].x), bfhi(w[sl][j].x), bflo(w[sl][j].y), bfhi(w[sl][j].y)};
            v[j] = v[j] + p * (*(const f32x4*)(A0 + gate_chunk * D + k) * gs); }
        a += (v[j].x * v[j].x + v[j].y * v[j].y) + (v[j].z * v[j].z + v[j].w * v[j].w); }
    const float rstd = 1.0f / sqrtf(wave_sum(a) * (1.0f / D) + EPS);
#pragma unroll
    for (int j = 0; j < 4; ++j) { const int k = 4 * lane + 256 * j; f32x4 g = *(const f32x4*)(ln + k), sf = (f32x4){0.f, 0.f, 0.f, 0.f};
        if (!FINAL) { g = g * (*(const f32x4*)(A0 + (shift_chunk + 1) * D + k) + 1.0f); sf = *(const f32x4*)(A0 + shift_chunk * D + k); }
        const f32x4 o = v[j] * rstd * g + sf;
        if (FINAL) *(f32x4*)(Yout + (size_t)row * D + k) = o;
        else { if (NSLAB > 0) *(f32x4*)(Xw + (size_t)row * D + k) = v[j]; v2u pw; pw.x = pk2(o.x, o.y); pw.y = pk2(o.z, o.w); *(GAS v2u*)(Hout + (size_t)row * D + k) = pw; } }
}
template <bool FINAL>
__device__ __forceinline__ void norm_group(Frame& F, const float* xp, const float* xs, const float* ln, int shift_chunk, bf16* Hout, float* Yout, int grp) {
    const int lane = otid() & 63, r0 = grp * 8, q = seq_of(r0);
    const float* ADA = (const float*)(KWS + WS_ADA) + (size_t)q * NADA + shift_chunk * D;
    f32x4 g[4], s[4];
#pragma unroll
    for (int j = 0; j < 4; ++j) { const int k = 4 * lane + 256 * j; g[j] = *(const f32x4*)(ln + k);
        if (!FINAL) { g[j] = g[j] * (*(const f32x4*)(ADA + D + k) + 1.0f); s[j] = *(const f32x4*)(ADA + k); } else s[j] = (f32x4){0.f, 0.f, 0.f, 0.f}; }
#pragma unroll
    for (int hb = 0; hb < 2; ++hb) {
        f32x4 v[4][4]; float ss[4];
#pragma unroll
        for (int rr = 0; rr < 4; ++rr) { const int row = r0 + hb * 4 + rr; const float* xr = (row < MP ? xp + (size_t)row * D : xs + (size_t)(row - MP) * D) + 4 * lane; float a = 0.f;
#pragma unroll
            for (int j = 0; j < 4; ++j) { v[rr][j] = *(const f32x4*)(xr + 256 * j); a += (v[rr][j].x * v[rr][j].x + v[rr][j].y * v[rr][j].y) + (v[rr][j].z * v[rr][j].z + v[rr][j].w * v[rr][j].w); }
            ss[rr] = a; }
#pragma unroll
        for (int rr = 0; rr < 4; ++rr) { const int row = r0 + hb * 4 + rr; const float rstd = 1.0f / sqrtf(wave_sum(ss[rr]) * (1.0f / D) + EPS);
#pragma unroll
            for (int j = 0; j < 4; ++j) { const f32x4 o = v[rr][j] * rstd * g[j] + s[j];
                if (FINAL) *(f32x4*)(Yout + (size_t)row * D + 4 * lane + 256 * j) = o;
                else { v2u w; w.x = pk2(o.x, o.y); w.y = pk2(o.z, o.w); *(GAS v2u*)(Hout + (size_t)row * D + 4 * lane + 256 * j) = w; } } }
    }
}

template <int PITCH>
__device__ __forceinline__ bf16x8 tr8(unsigned img, int row0, int col0, int lane) {
    const unsigned addr = img + (unsigned)((row0 + 8 * (lane >> 4) + ((lane & 15) >> 2)) * PITCH + (col0 + 4 * (lane & 3)) * 2);
    s16x4 lo, hi;
    asm volatile("ds_read_b64_tr_b16 %0, %2\n\tds_read_b64_tr_b16 %1, %2 offset:%3\n\ts_waitcnt lgkmcnt(0)" : "=&v"(lo), "=&v"(hi) : "v"(addr), "i"(4 * PITCH) : "memory");
    return (bf16x8){lo[0], lo[1], lo[2], lo[3], hi[0], hi[1], hi[2], hi[3]};
}

constexpr int G_QIN = 0, G_KIN = 9216, G_KDEC = 18432, G_ATT = 27648, G_VIM = 36864, G_SPV = 54272, G_OST = 71680, G_DEC = 105472, G_END = 105728;
template <int MODE>
__device__ __forceinline__ void gla_item(Frame& F, int item) {
    constexpr int CV = MODE == 2 ? 8 : 64, MT = MODE == 2 ? 1 : 4, KS = MODE == 2 ? 1 : 2;
    const int tid = otid(), lane = tid & 63, w = __builtin_amdgcn_readfirstlane(tid >> 6), fr = lane & 15, fq = lane >> 4;
    int q, h, r0, slot;
    if (MODE == 2) { q = item >> 2; h = item & 3; r0 = MP + 8 * q; slot = 0; }
    else { h = item & 3; const int n = (item >> 2) & 31; q = item >> 7; r0 = q * 2048 + n * 64; slot = (q * 4 + h) * 32 + n; }
    LAS unsigned char* L = F.lds; const unsigned Lb = (unsigned)(size_t)L;
    const bf16* PROJ = (const bf16*)(KWS + WS_PROJ);
    {
        const bool valid = lane < CV; const bf16* prow = PROJ + (size_t)(r0 + (valid ? lane : 0)) * NIN;
        float glr[16];
        { const v4u g0 = *(const v4u*)(prow + PJ_GLR), g1 = *(const v4u*)(prow + PJ_GLR + 8);
#pragma unroll
          for (int i = 0; i < 4; ++i) { glr[2 * i] = bflo(g0[i]); glr[2 * i + 1] = bfhi(g0[i]); glr[8 + 2 * i] = bflo(g1[i]); glr[9 + 2 * i] = bfhi(g1[i]); } }
        const float* w2 = KIN(14) + h * 64 + 8 * w; const float* b2 = KIN(15) + h * 64 + 8 * w;
        float la[8];
#pragma unroll
        for (int j = 0; j < 8; ++j) { float g = b2[j];
#pragma unroll
            for (int r = 0; r < 16; ++r) g += glr[r] * w2[r * 256 + j];
            const float ls = fminf(g, 0.f) - __logf(1.0f + __expf(-fabsf(g)));
            la[j] = valid ? ls * (1.0f / 16.0f) : 0.f; }
#pragma unroll
        for (int off = 1; off < 64; off <<= 1)
#pragma unroll
            for (int j = 0; j < 8; ++j) { const float t = __shfl_up(la[j], off); if (lane >= off) la[j] += t; }
        float bl[8];
#pragma unroll
        for (int j = 0; j < 8; ++j) bl[j] = __shfl(la[j], CV - 1);
        v4u q8 = (v4u){0u, 0u, 0u, 0u}, k8 = (v4u){0u, 0u, 0u, 0u};
        if (valid) { if (MODE != 0) q8 = *(const v4u*)(prow + PJ_Q + h * 64 + 8 * w); k8 = *(const v4u*)(prow + PJ_K + h * 64 + 8 * w); }
        v4u oq, ok, od;
#pragma unroll
        for (int i = 0; i < 4; ++i) { const float e0 = __expf(la[2 * i]), e1 = __expf(la[2 * i + 1]), n0 = __expf(-la[2 * i]), n1 = __expf(-la[2 * i + 1]);
            const float d0 = __expf(bl[2 * i] - la[2 * i]), d1 = __expf(bl[2 * i + 1] - la[2 * i + 1]);
            oq[i] = pk2(bflo(q8[i]) * e0 * 0.125f, bfhi(q8[i]) * e1 * 0.125f); ok[i] = pk2(bflo(k8[i]) * n0, bfhi(k8[i]) * n1); od[i] = pk2(bflo(k8[i]) * d0, bfhi(k8[i]) * d1); }
        if (MODE != 0) { *(LAS v4u*)(L + G_QIN + lane * 144 + 16 * w) = oq; *(LAS v4u*)(L + G_KIN + lane * 144 + 16 * w) = ok; }
        if (MODE != 1) *(LAS v4u*)(L + G_KDEC + lane * 144 + 16 * w) = od;
        if (MODE == 0 && lane < 8) { float v = bl[0];
#pragma unroll
            for (int j = 1; j < 8; ++j) v = lane == j ? bl[j] : v;
            ((float*)(KWS + WS_DEC))[slot * 64 + 8 * w + lane] = __expf(v); }
        if (MODE == 2 && lane < 8) { float v = bl[0];
#pragma unroll
            for (int j = 1; j < 8; ++j) v = lane == j ? bl[j] : v;
            ((LAS float*)(L + G_DEC))[8 * w + lane] = __expf(v); }
    }
#pragma unroll
    for (int i = 0; i < 2; ++i) { const int id = tid + 512 * i, s = id >> 4, ch = id & 15; v4u v = (v4u){0u, 0u, 0u, 0u};
        if (s < CV) v = *(const v4u*)(PROJ + (size_t)(r0 + s) * NIN + PJ_V + h * 128 + 8 * ch);
        *(LAS v4u*)(L + G_VIM + s * 272 + 16 * ch) = v; }
    if (MODE == 1) { const bf16* SP = (const bf16*)(KWS + WS_SPREV) + (size_t)slot * 8192;
#pragma unroll
        for (int i = 0; i < 2; ++i) { const int id = tid + 512 * i, d = id >> 4, ch = id & 15; *(LAS v4u*)(L + G_SPV + d * 272 + 16 * ch) = *(const v4u*)(SP + d * 128 + 8 * ch); } }
    if (MODE == 2) { const float* S0 = KIN(3) + (size_t)item * 8192;
#pragma unroll
        for (int i = 0; i < 2; ++i) { const int id = tid + 512 * i, d = id >> 4, ch = id & 15; const f32x4 a = *(const f32x4*)(S0 + d * 128 + 8 * ch), b = *(const f32x4*)(S0 + d * 128 + 8 * ch + 4);
            v4u v; v.x = pk2(a.x, a.y); v.y = pk2(a.z, a.w); v.z = pk2(b.x, b.y); v.w = pk2(b.z, b.w); *(LAS v4u*)(L + G_SPV + d * 272 + 16 * ch) = v; } }
    __syncthreads();
#if DIAG
    if (MODE == 0) { unsigned bad_ = 0;
        for (int i = 0; i < 2; ++i) { const int id = tid + 512 * i, s_ = id >> 4, ch = id & 15; const v4u a_ = *(const LAS v4u*)(L + G_VIM + s_ * 272 + 16 * ch);
            const v4u b_ = __builtin_nontemporal_load((const v4u*)(PROJ + (size_t)(r0 + s_) * NIN + PJ_V + h * 128 + 8 * ch));
            bad_ += (a_.x != b_.x) + (a_.y != b_.y) + (a_.z != b_.z) + (a_.w != b_.w); }
        if (bad_) { __hip_atomic_fetch_max(F.ctl + CW_DG, (unsigned)(64 - 9), RLX_AGENT); __hip_atomic_fetch_add(F.ctl + CW_DG + 64 * (1 + 9), bad_, RLX_AGENT); } }
    if (MODE == 0 && slot < 64) { bf16* DK = (bf16*)(KWS + 241 * MiB) + (size_t)slot * 12288;
        for (int id = tid; id < 64 * 8; id += 512) { const int r_ = id >> 3, c_ = id & 7; *(GAS v4u*)(DK + r_ * 64 + 8 * c_) = *(const LAS v4u*)(L + G_KDEC + r_ * 144 + 16 * c_); }
        for (int id = tid; id < 64 * 16; id += 512) { const int r_ = id >> 4, c_ = id & 15; *(GAS v4u*)(DK + 4096 + r_ * 128 + 8 * c_) = *(const LAS v4u*)(L + G_VIM + r_ * 272 + 16 * c_); } }
#endif
    if (MODE != 0) {
        if ((w >> 1) < MT && (MODE == 1 || (w & 1) == 0)) { const int mt = w >> 1;
#pragma unroll
            for (int nn = 0; nn < 2; ++nn) { const int nt = 2 * (w & 1) + nn; f32x4 acc = (f32x4){0.f, 0.f, 0.f, 0.f};
#pragma unroll
                for (int k2 = 0; k2 < 2; ++k2) { const bf16x8 a = *(const LAS bf16x8*)(L + G_QIN + (16 * mt + fr) * 144 + (32 * k2 + 8 * fq) * 2), b = *(const LAS bf16x8*)(L + G_KIN + (16 * nt + fr) * 144 + (32 * k2 + 8 * fq) * 2);
                    acc = __builtin_amdgcn_mfma_f32_16x16x32_bf16(a, b, acc, 0, 0, 0); }
#pragma unroll
                for (int r = 0; r < 4; ++r) { const int cc = 16 * mt + 4 * fq + r, ss = 16 * nt + fr; const float v = ss <= cc ? acc[r] : 0.f;
                    *(LAS unsigned short*)(L + G_ATT + cc * 144 + ss * 2) = (unsigned short)pg8::bf16_rne_bits(v); } } }
        __syncthreads();
    }
    bf16x8 bv[KS];
#pragma unroll
    for (int k = 0; k < KS; ++k) bv[k] = tr8<272>(Lb + G_VIM, 32 * k, 16 * w, lane);
    if (MODE != 0) {
        bf16x8 bs[2];
#pragma unroll
        for (int k2 = 0; k2 < 2; ++k2) bs[k2] = tr8<272>(Lb + G_SPV, 32 * k2, 16 * w, lane);
#pragma unroll
        for (int mt = 0; mt < MT; ++mt) { f32x4 acc = (f32x4){0.f, 0.f, 0.f, 0.f};
#pragma unroll
            for (int k = 0; k < KS; ++k) { const bf16x8 a = *(const LAS bf16x8*)(L + G_ATT + (16 * mt + fr) * 144 + (32 * k + 8 * fq) * 2); acc = __builtin_amdgcn_mfma_f32_16x16x32_bf16(a, bv[k], acc, 0, 0, 0); }
#pragma unroll
            for (int k2 = 0; k2 < 2; ++k2) { const bf16x8 a = *(const LAS bf16x8*)(L + G_QIN + (16 * mt + fr) * 144 + (32 * k2 + 8 * fq) * 2); acc = __builtin_amdgcn_mfma_f32_16x16x32_bf16(a, bs[k2], acc, 0, 0, 0); }
#pragma unroll
            for (int r = 0; r < 4; ++r) ((LAS float*)(L + G_OST))[(16 * mt + 4 * fq + r) * 132 + 16 * w + fr] = acc[r]; }
    }
    if (MODE != 1) {
#pragma unroll
        for (int mt = 0; mt < 4; ++mt) { f32x4 acc = (f32x4){0.f, 0.f, 0.f, 0.f};
#pragma unroll
            for (int k = 0; k < KS; ++k) { const bf16x8 a = tr8<144>(Lb + G_KDEC, 32 * k, 16 * mt, lane); acc = __builtin_amdgcn_mfma_f32_16x16x32_bf16(a, bv[k], acc, 0, 0, 0); }
            if (MODE == 0) {
#pragma unroll
                for (int r = 0; r < 4; ++r) *(LAS unsigned short*)(L + G_SPV + (16 * mt + 4 * fq + r) * 272 + (16 * w + fr) * 2) = (unsigned short)pg8::bf16_rne_bits(acc[r]);
            } else { const float* S0 = KIN(3) + (size_t)item * 8192; float* So = KOUT + OUT_GLAS + (size_t)item * 8192;
#pragma unroll
                for (int r = 0; r < 4; ++r) { const int d = 16 * mt + 4 * fq + r, e = 16 * w + fr; So[d * 128 + e] = ((LAS float*)(L + G_DEC))[d] * S0[d * 128 + e] + acc[r]; } }
        }
    }
    __syncthreads();
    if (MODE == 0) { bf16* U = (bf16*)(KWS + WS_UPD) + (size_t)slot * 8192;
#pragma unroll
        for (int i = 0; i < 2; ++i) { const int id = tid + 512 * i, d = id >> 4, ch = id & 15; *(GAS v4u*)(U + d * 128 + 8 * ch) = *(const LAS v4u*)(L + G_SPV + d * 272 + 16 * ch); } }
    if (MODE != 0) { const int c = tid >> 3, seg = tid & 7;
        if (c < CV) {
            float o[16]; float ssq = 0.f;
#pragma unroll
            for (int i = 0; i < 4; ++i) { const f32x4 t = *(const LAS f32x4*)(L + G_OST + (c * 132 + 16 * seg + 4 * i) * 4); o[4 * i] = t.x; o[4 * i + 1] = t.y; o[4 * i + 2] = t.z; o[4 * i + 3] = t.w; ssq += (t.x * t.x + t.y * t.y) + (t.z * t.z + t.w * t.w); }
            ssq += __shfl_xor(ssq, 1); ssq += __shfl_xor(ssq, 2); ssq += __shfl_xor(ssq, 4);
            const float rstd = 1.0f / sqrtf(ssq * (1.0f / 128.0f) + EPS);
            const bf16* ogp = PROJ + (size_t)(r0 + c) * NIN + PJ_OG + h * 128 + 16 * seg; const v4u g0 = *(const v4u*)ogp, g1 = *(const v4u*)(ogp + 8);
            const float* gn = KIN(18) + 16 * seg; v4u o0, o1;
#pragma unroll
            for (int i = 0; i < 4; ++i) { o0[i] = pk2(o[2 * i] * rstd * gn[2 * i] * silu_f(bflo(g0[i])), o[2 * i + 1] * rstd * gn[2 * i + 1] * silu_f(bfhi(g0[i])));
                o1[i] = pk2(o[8 + 2 * i] * rstd * gn[8 + 2 * i] * silu_f(bflo(g1[i])), o[9 + 2 * i] * rstd * gn[9 + 2 * i] * silu_f(bfhi(g1[i]))); }
            bf16* zp = (bf16*)(KWS + WS_ZO) + (size_t)(r0 + c) * D + 512 + h * 128 + 16 * seg; *(GAS v4u*)zp = o0; *(GAS v4u*)(zp + 8) = o1;
        }
    }
    __syncthreads();
}

constexpr int P_UIM = 0, P_WPI = 50176, P_OUT = 84992, P_END = 119808;
__device__ __forceinline__ void pool_item(Frame& F, int item) {
    const int tid = otid(), lane = tid & 63, w = __builtin_amdgcn_readfirstlane(tid >> 6), fr = lane & 15, fq = lane >> 4;
    const int g = item & 3, blk = item >> 2; const bool smp = blk >= 128; const int Wn = 2 << g;
    const int t0 = smp ? MP + 64 * (blk - 128) : 128 * blk;
    LAS unsigned char* L = F.lds; const bf16* PROJ = (const bf16*)(KWS + WS_PROJ);
    { const bf16* WP = (const bf16*)(KWS + WS_WPT) + g * 16384;
#pragma unroll
      for (int i = 0; i < 4; ++i) { const int id = tid + 512 * i, n = id >> 4, ch = id & 15; *(LAS v4u*)(L + P_WPI + n * 272 + 16 * ch) = *(const v4u*)(WP + n * 128 + 8 * ch); } }
    if (!smp) { const int seq0 = t0 & ~2047;
        for (int id = tid; id < 143 * 16; id += 512) { const int i = id >> 4, ch = id & 15, row = t0 - 15 + i; v4u v = (v4u){0u, 0u, 0u, 0u};
            if (row >= seq0) v = *(const v4u*)(PROJ + (size_t)row * NIN + PJ_U + g * 128 + 8 * ch);
            *(LAS v4u*)(L + P_UIM + i * 272 + 16 * ch) = v; }
    } else { const int s0 = (blk - 128) * 8;
        for (int id = tid; id < 184 * 16; id += 512) { const int ir = id >> 4, ch = id & 15, sl = ir / 23, i = ir % 23; v4u v;
            if (i < 15) { const float* sp = KIN(2) + ((size_t)(s0 + sl) * 15 + i) * 512 + g * 128 + 8 * ch; const f32x4 a = *(const f32x4*)sp, b = *(const f32x4*)(sp + 4);
                v.x = pk2(a.x, a.y); v.y = pk2(a.z, a.w); v.z = pk2(b.x, b.y); v.w = pk2(b.z, b.w); }
            else v = *(const v4u*)(PROJ + (size_t)(t0 + sl * 8 + i - 15) * NIN + PJ_U + g * 128 + 8 * ch);
            *(LAS v4u*)(L + P_UIM + ir * 272 + 16 * ch) = v; }
    }
    __syncthreads();
    const int nmt = smp ? 4 : 8;
    if (w < nmt) {
        const int tl = 16 * w + fr; const int ib = smp ? 23 * (tl >> 3) + 15 + (tl & 7) : 15 + tl;
        int cnt = Wn; if (!smp) { const int pos = (t0 + tl) & 2047; cnt = pos + 1 < Wn ? pos + 1 : Wn; }
        const float rc = 1.0f / (float)cnt;
        bf16x8 a[4];
#pragma unroll
        for (int k = 0; k < 4; ++k) { float sum[8];
#pragma unroll
            for (int j = 0; j < 8; ++j) sum[j] = 0.f;
            const LAS unsigned char* p0 = L + P_UIM + ib * 272 + (32 * k + 8 * fq) * 2;
            for (int i = 0; i < Wn; ++i) { const v4u v = *(const LAS v4u*)(p0 - i * 272);
#pragma unroll
                for (int j = 0; j < 4; ++j) { sum[2 * j] += bflo(v[j]); sum[2 * j + 1] += bfhi(v[j]); } }
            const v4u cur = *(const LAS v4u*)p0; union { bf16x8 v; unsigned u[4]; } t;
#pragma unroll
            for (int j = 0; j < 4; ++j) t.u[j] = pk2(sum[2 * j] * rc - bflo(cur[j]), sum[2 * j + 1] * rc - bfhi(cur[j]));
            a[k] = t.v; }
        const float* psc = KIN(17) + g * 128;
#pragma unroll
        for (int nt = 0; nt < 8; ++nt) { f32x4 acc = (f32x4){0.f, 0.f, 0.f, 0.f};
#pragma unroll
            for (int k = 0; k < 4; ++k) { const bf16x8 b = *(const LAS bf16x8*)(L + P_WPI + (16 * nt + fr) * 272 + (32 * k + 8 * fq) * 2); acc = __builtin_amdgcn_mfma_f32_16x16x32_bf16(a[k], b, acc, 0, 0, 0); }
            const float sc = psc[16 * nt + fr];
#pragma unroll
            for (int r = 0; r < 4; ++r) *(LAS unsigned short*)(L + P_OUT + (16 * w + 4 * fq + r) * 272 + (16 * nt + fr) * 2) = (unsigned short)pg8::bf16_rne_bits(acc[r] * sc); }
    }
    __syncthreads();
    { bf16* ZO = (bf16*)(KWS + WS_ZO); const int nch = (smp ? 64 : 128) * 16;
      for (int id = tid; id < nch; id += 512) { const int row = id >> 4, ch = id & 15; *(GAS v4u*)(ZO + (size_t)(t0 + row) * D + g * 128 + 8 * ch) = *(const LAS v4u*)(L + P_OUT + row * 272 + 16 * ch); } }
    __syncthreads();
}
__device__ __forceinline__ void pool_state_copies(Frame& F) {
    const bf16* PROJ = (const bf16*)(KWS + WS_PROJ);
    const int NP = 8 * 15 * 128, NS = 128 * 15 * 128;
    for (int id = blockIdx.x * 512 + otid(); id < NP + NS; id += F.G * 512) {
        if (id < NP) { const int c4 = id & 127, i = (id >> 7) % 15, b = id / (15 * 128); const v2u v = *(const v2u*)(PROJ + (size_t)(b * 2048 + 2033 + i) * NIN + PJ_U + 4 * c4);
            *(f32x4*)(KOUT + OUT_POOLP + (size_t)id * 4) = (f32x4){bflo(v.x), bfhi(v.x), bflo(v.y), bfhi(v.y)}; }
        else { const int j = id - NP, c4 = j & 127, i = (j >> 7) % 15, s = j / (15 * 128); f32x4 o;
            if (i < 7) o = *(const f32x4*)(KIN(2) + ((size_t)s * 15 + 8 + i) * 512 + 4 * c4);
            else { const v2u v = *(const v2u*)(PROJ + (size_t)(MP + 8 * s + i - 7) * NIN + PJ_U + 4 * c4); o = (f32x4){bflo(v.x), bfhi(v.x), bflo(v.y), bfhi(v.y)}; }
            *(f32x4*)(KOUT + OUT_POOLS + (size_t)j * 4) = o; }
    }
}
__device__ __forceinline__ void gla_scan(Frame& F) {
    const int tid = otid(); if (tid >= 128) return;
    for (int b = blockIdx.x; b < 256; b += F.G) {
    const int qh = b >> 3, d = 8 * (b & 7) + (tid >> 4), ch = tid & 15;
    const bf16* U = (const bf16*)(KWS + WS_UPD) + (size_t)qh * 32 * 8192 + d * 128 + 8 * ch; bf16* SPo = (bf16*)(KWS + WS_SPREV) + (size_t)qh * 32 * 8192 + d * 128 + 8 * ch; const float* DC = (const float*)(KWS + WS_DEC) + qh * 32 * 64 + d;
    float S[8];
#pragma unroll
    for (int j = 0; j < 8; ++j) S[j] = 0.f;
#pragma unroll 1
    for (int hb = 0; hb < 2; ++hb) {
        v4u u[16]; float dc[16];
#pragma unroll
        for (int n = 0; n < 16; ++n) { u[n] = *(const v4u*)(U + (size_t)(16 * hb + n) * 8192); dc[n] = DC[(16 * hb + n) * 64]; }
#pragma unroll
        for (int n = 0; n < 16; ++n) { v4u o;
#pragma unroll
            for (int j = 0; j < 4; ++j) { o[j] = pk2(S[2 * j], S[2 * j + 1]); S[2 * j] = dc[n] * S[2 * j] + bflo(u[n][j]); S[2 * j + 1] = dc[n] * S[2 * j + 1] + bfhi(u[n][j]); }
            *(GAS v4u*)(SPo + (size_t)(16 * hb + n) * 8192) = o; }
    }
    float* So = KOUT + OUT_GLAP + ((size_t)qh * 64 + d) * 128 + 8 * ch;
    *(f32x4*)So = (f32x4){S[0], S[1], S[2], S[3]}; *(f32x4*)(So + 4) = (f32x4){S[4], S[5], S[6], S[7]};
    }
}


#if DIAG
constexpr size_t WS_DGBUF = 240 * MiB;
__device__ __forceinline__ unsigned dg_hash(unsigned i, unsigned seed) { unsigned h = i * 2654435761u + seed * 0x9e3779b9u; h ^= h >> 16; h *= 0x85ebca6bu; h ^= h >> 13; h *= 0xc2b2ae35u; h ^= h >> 16; return h; }
__device__ __forceinline__ void dg_cmp(gu32* ctl, int stage, float got, float want, float scale) {
    const float err = fabsf(got - want); const bool bad = !(err <= 0.03f * fabsf(want) + 0.03f * scale);
    if (bad) { __hip_atomic_fetch_max(ctl + CW_DG, (unsigned)(64 - stage), RLX_AGENT); __hip_atomic_fetch_add(ctl + CW_DG + 64 * (1 + stage), 1u, RLX_AGENT); }
}
__device__ __forceinline__ float bf1(const bf16* p) { return __uint_as_float((unsigned)(*p) << 16); }
__device__ __forceinline__ int dg_row(unsigned h) { return (h & 1u) ? MP + (int)((h >> 1) % MS) : (int)((h >> 1) % MP); }
__device__ __forceinline__ const float* dg_xrow(const float* xp, const float* xs, int row) { return row < MP ? xp + (size_t)row * D : xs + (size_t)(row - MP) * D; }
#define DG_I (blockIdx.x * 512 + otid())
#define DG_ON (blockIdx.x < 8)
__device__ __forceinline__ void dg_ada(Frame& F, int stage) { if (!DG_ON) return; const unsigned h = dg_hash(DG_I, stage); const int q = h % NSEQ, n = (h >> 8) % NADA;
    const float* c = q < 8 ? KIN(4) + (size_t)q * D : KIN(5) + (size_t)(q - 8) * D; const float* W = KIN(9); float a = KIN(10)[n];
    for (int k = 0; k < D; ++k) a += silu_f(c[k]) * W[(size_t)k * NADA + n];
    dg_cmp(F.ctl, stage, ((const float*)(KWS + WS_ADA))[(size_t)q * NADA + n], a, 1.f); }
__device__ __forceinline__ void dg_wts(Frame& F, int stage) { if (!DG_ON) return; const int i = DG_I; const unsigned h = dg_hash(i, stage); unsigned char* ws = KWS;
    const int t = i % 5;
    if (t == 0) { const int j = (h >> 3) % FF, k = (h >> 16) % D, row = 256 * (j >> 7) + (j & 127);
        dg_cmp(F.ctl, stage, bf1((const bf16*)(ws + WS_W1U) + (size_t)row * D + k), KIN(11)[(size_t)k * NUP + j], 0.02f); dg_cmp(F.ctl, stage, bf1((const bf16*)(ws + WS_W1U) + (size_t)(row + 128) * D + k), KIN(11)[(size_t)k * NUP + FF + j], 0.02f);
        dg_cmp(F.ctl, stage, bf1((const bf16*)(ws + WS_W2U) + (size_t)row * D + k), KIN(20)[(size_t)k * NUP + j], 0.02f); dg_cmp(F.ctl, stage, bf1((const bf16*)(ws + WS_W2U) + (size_t)(row + 128) * D + k), KIN(20)[(size_t)k * NUP + FF + j], 0.02f); }
    else if (t == 1) { const int c = h % D, j = (h >> 10) % FF;
        dg_cmp(F.ctl, stage, bf1((const bf16*)(ws + WS_W1D) + (size_t)c * FF + j), KIN(12)[(size_t)j * D + c], 0.01f); dg_cmp(F.ctl, stage, bf1((const bf16*)(ws + WS_W2D) + (size_t)c * FF + j), KIN(21)[(size_t)j * D + c], 0.01f); }
    else if (t == 2) { const int r = h % NIN, k = (h >> 12) % D; const int src = r < 1536 ? r : (r < 2048 ? 1552 + (r - 1536) : (r < 2064 ? 1536 + (r - 2048) : -1));
        dg_cmp(F.ctl, stage, bf1((const bf16*)(ws + WS_WIN) + (size_t)r * D + k), src < 0 ? 0.f : KIN(13)[(size_t)k * DIN + src], 0.02f); }
    else if (t == 3) { const int n = h % D, k = (h >> 10) % D; dg_cmp(F.ctl, stage, bf1((const bf16*)(ws + WS_WOUT) + (size_t)n * D + k), KIN(19)[(size_t)k * D + n], 0.02f); }
    else { const int g = h & 3, n = (h >> 2) & 127, k = (h >> 9) & 127; dg_cmp(F.ctl, stage, bf1((const bf16*)(ws + WS_WPT) + g * 16384 + n * 128 + k), KIN(16)[g * 16384 + k * 128 + n], 0.05f); } }
__device__ __forceinline__ void dg_h(Frame& F, int stage, const float* xp, const float* xs, const float* ln, int chunk) { if (!DG_ON) return; const unsigned h = dg_hash(DG_I, stage); const int row = dg_row(h), k = (h >> 16) % D, q = seq_of(row);
    const float* x = dg_xrow(xp, xs, row); float ss = 0.f; for (int i = 0; i < D; ++i) ss += x[i] * x[i];
    const float* A = (const float*)(KWS + WS_ADA) + (size_t)q * NADA + chunk * D;
    const float want = x[k] * (1.0f / sqrtf(ss / D + EPS)) * ln[k] * (1.0f + A[D + k]) + A[k];
    dg_cmp(F.ctl, stage, bf1((const bf16*)(KWS + WS_H) + (size_t)row * D + k), want, 1.f); }
__device__ __forceinline__ void dg_act(Frame& F, int stage, const float* wup) { if (!DG_ON) return; const unsigned h = dg_hash(DG_I, stage); const int row = dg_row(h), j = (h >> 12) % FF;
    const bf16* H = (const bf16*)(KWS + WS_H) + (size_t)row * D; float g = 0.f, u = 0.f;
    for (int k = 0; k < D; ++k) { const float x = bf1(H + k); g += x * wup[(size_t)k * NUP + j]; u += x * wup[(size_t)k * NUP + FF + j]; }
    dg_cmp(F.ctl, stage, bf1((const bf16*)(KWS + WS_ACT) + (size_t)row * FF + j), silu_f(g) * u, 0.5f); }
__device__ __forceinline__ void dg_x(Frame& F, int stage, const bf16* A, int K, const float* W, int chunk, float gs, bool first, bool prompt_only) { if (!DG_ON) return; const int i = DG_I; const unsigned h = dg_hash(i, 77); const int row = dg_row(h), c = (h >> 14) % D, q = seq_of(row);
    if (prompt_only && row >= MP) return;
    float* buf = (float*)(KWS + WS_DGBUF); const float base = first ? dg_xrow(KIN(0), KIN(1), row)[c] : buf[i];
    float a = 0.f; for (int j = 0; j < K; ++j) a += bf1(A + (size_t)row * K + j) * W[(size_t)j * D + c];
    const float want = base + gs * ((const float*)(KWS + WS_ADA))[(size_t)q * NADA + chunk * D + c] * a; const float got = (KOUT + OUT_X)[(size_t)row * D + c];
    dg_cmp(F.ctl, stage, got, want, 1.f); buf[i] = got; }
__device__ __forceinline__ void dg_proj(Frame& F, int stage) { if (!DG_ON) return; const unsigned h = dg_hash(DG_I, stage); const int row = dg_row(h), r = (h >> 12) % NIN;
    const int src = r < 1536 ? r : (r < 2048 ? 1552 + (r - 1536) : (r < 2064 ? 1536 + (r - 2048) : -1));
    const bf16* H = (const bf16*)(KWS + WS_H) + (size_t)row * D; const float* W = KIN(13); float a = 0.f;
    if (src >= 0) for (int k = 0; k < D; ++k) a += bf1(H + k) * W[(size_t)k * DIN + src];
    dg_cmp(F.ctl, stage, bf1((const bf16*)(KWS + WS_PROJ) + (size_t)row * NIN + r), a, 1.f); }
__device__ __forceinline__ void dg_pool(Frame& F, int stage) { if (!DG_ON) return; const unsigned h = dg_hash(DG_I, stage); const int row = dg_row(h), ch = (h >> 14) & 511, g = ch >> 7, n = ch & 127, Wn = 2 << g;
    const bf16* P = (const bf16*)(KWS + WS_PROJ); const float* wp = KIN(16) + g * 16384; const bool smp = row >= MP; const int tt = smp ? ((row - MP) & 7) : (row & 2047), sq = smp ? ((row - MP) >> 3) : 0;
    const int cnt = smp ? Wn : (tt + 1 < Wn ? tt + 1 : Wn); float z = 0.f;
    for (int k = 0; k < 128; ++k) { float s = 0.f;
        for (int i = 0; i < Wn; ++i) { float v = 0.f; if (tt - i >= 0) v = bf1(P + (size_t)(row - i) * NIN + g * 128 + k); else if (smp) v = KIN(2)[((size_t)sq * 15 + 15 + (tt - i)) * 512 + g * 128 + k]; s += v; }
        z += (s / (float)cnt - bf1(P + (size_t)row * NIN + g * 128 + k)) * wp[k * 128 + n]; }
    dg_cmp(F.ctl, stage, bf1((const bf16*)(KWS + WS_ZO) + (size_t)row * D + ch), z * KIN(17)[ch], 0.5f);
    { const int ii = (h >> 3) % 15, c2 = (h >> 8) & 511; const int b = (h >> 20) & 7, s = (h >> 20) & 127;
      dg_cmp(F.ctl, stage + 1, (KOUT + OUT_POOLP)[((size_t)b * 15 + ii) * 512 + c2], bf1(P + (size_t)(b * 2048 + 2033 + ii) * NIN + c2), 0.5f);
      const float want = ii < 7 ? KIN(2)[((size_t)s * 15 + 8 + ii) * 512 + c2] : bf1(P + (size_t)(MP + 8 * s + ii - 7) * NIN + c2);
      dg_cmp(F.ctl, stage + 1, (KOUT + OUT_POOLS)[((size_t)s * 15 + ii) * 512 + c2], want, 0.5f); } }

__device__ __forceinline__ void dg_upd(Frame& F, int stage) { if (!DG_ON) return; const unsigned h = dg_hash(DG_I, stage); const int slot = (DG_I & 1) ? (h & 63) : (h & 1023), dd = (h >> 10) & 63, e = (h >> 16) & 127;
    const int qh = slot >> 5, n = slot & 31, q = qh >> 2, hd = qh & 3, r0 = q * 2048 + n * 64; const bf16* P = (const bf16*)(KWS + WS_PROJ);
    const float* w2 = KIN(14) + hd * 64 + dd; const float b2 = KIN(15)[hd * 64 + dd]; float bs[64]; float b = 0.f;
#pragma unroll 1
    for (int s = 0; s < 64; ++s) { const bf16* pr = P + (size_t)(r0 + s) * NIN; float g = b2; for (int r = 0; r < 16; ++r) g += bf1(pr + PJ_GLR + r) * w2[r * 256];
        b += (fminf(g, 0.f) - logf(1.0f + expf(-fabsf(g)))) * (1.0f / 16.0f); ((LAS float*)F.lds)[s * 512 + otid()] = b; }
    float u = 0.f;
#pragma unroll 1
    for (int s = 0; s < 64; ++s) { const bf16* pr = P + (size_t)(r0 + s) * NIN; u += bf1(pr + PJ_K + hd * 64 + dd) * expf(b - ((LAS float*)F.lds)[s * 512 + otid()]) * bf1(pr + PJ_V + hd * 128 + e); }
    if (slot < 64) { const int s_ = (h >> 23) & 63; const bf16* DK = (const bf16*)(KWS + 241 * MiB) + (size_t)slot * 12288; const bf16* pr = P + (size_t)(r0 + s_) * NIN;
        dg_cmp(F.ctl, stage + 1, bf1(DK + s_ * 64 + dd), bf1(pr + PJ_K + hd * 64 + dd) * expf(b - ((LAS float*)F.lds)[s_ * 512 + otid()]), 0.3f);
        { const bf16* Hr = (const bf16*)(KWS + WS_H) + (size_t)(r0 + s_) * D; const float* Wv = KIN(13) + 1024 + hd * 128 + e; float tr = 0.f;
          for (int k = 0; k < D; ++k) tr += bf1(Hr + k) * Wv[(size_t)k * DIN];
          dg_cmp(F.ctl, stage + 2, bf1(pr + PJ_V + hd * 128 + e), tr, 1.f);
          dg_cmp(F.ctl, stage + 3, bf1(DK + 4096 + s_ * 128 + e), tr, 1.f); } }
#ifdef DG_MAXDIFF
    if (slot < 64) { const int s_ = (h >> 23) & 63; const bf16* DK = (const bf16*)(KWS + 241 * MiB) + (size_t)slot * 12288; const bf16* pr = P + (size_t)(r0 + s_) * NIN;
        const float a_ = bf1(DK + 4096 + s_ * 128 + e), b_ = bf1(pr + PJ_V + hd * 128 + e); const float df = fabsf(a_ - b_);
        if (df > 0.f) { __hip_atomic_fetch_max(F.ctl + CW_DG + 64 * 40, __float_as_uint(df), RLX_AGENT); __hip_atomic_fetch_max(F.ctl + CW_DG + 64 * 41, __float_as_uint(fabsf(b_)), RLX_AGENT); __hip_atomic_fetch_add(F.ctl + CW_DG + 64 * 42, 1u, RLX_AGENT); } }
#endif
    dg_cmp(F.ctl, stage + 4, bf1((const bf16*)(KWS + WS_UPD) + (size_t)slot * 8192 + dd * 128 + e), u, 6.f);
#ifdef DG_RELERR
    { const float g_ = bf1((const bf16*)(KWS + WS_UPD) + (size_t)slot * 8192 + dd * 128 + e); float re = fabsf(g_ - u) / (fabsf(u) + 0.5f); re = re < 4.f ? re : 4.f; if (!(re == re)) re = 4.f;
      __hip_atomic_fetch_add(F.ctl + CW_DG + 64 * 43, (unsigned)(re * 1024.f), RLX_AGENT); __hip_atomic_fetch_add(F.ctl + CW_DG + 64 * 44, 1u, RLX_AGENT);
      __hip_atomic_fetch_add(F.ctl + CW_DG + 64 * 45, (unsigned)(int)(g_ * u * 16.f), RLX_AGENT); __hip_atomic_fetch_add(F.ctl + CW_DG + 64 * 46, (unsigned)(int)(u * u * 16.f), RLX_AGENT); }
#endif
    dg_cmp(F.ctl, stage, ((const float*)(KWS + WS_DEC))[slot * 64 + dd], expf(b), 0.1f); (void)bs; }
__device__ __forceinline__ void dg_sprev(Frame& F, int stage) { if (!DG_ON) return; const unsigned h = dg_hash(DG_I, stage); const int qh = h & 31, n = (h >> 5) & 31, dd = (h >> 10) & 63, e = (h >> 16) & 127;
    float S = 0.f; for (int j = 0; j < n; ++j) { const int slot = qh * 32 + j; S = ((const float*)(KWS + WS_DEC))[slot * 64 + dd] * S + bf1((const bf16*)(KWS + WS_UPD) + (size_t)slot * 8192 + dd * 128 + e); }
    dg_cmp(F.ctl, stage, bf1((const bf16*)(KWS + WS_SPREV) + (size_t)(qh * 32 + n) * 8192 + dd * 128 + e), S, 10.f); }
__device__ __forceinline__ void dg_gla(Frame& F, int stage) { if (!DG_ON) return;
    const int tid_ = otid(), lane = tid_ & 63, wv = __builtin_amdgcn_readfirstlane(tid_ >> 6), gw = blockIdx.x * 8 + wv; const unsigned h = dg_hash(gw, stage);
    const bool smp = gw >= 40; const int hd = (h >> 3) & 3; int seqi, t, rbase; bool last;
    if (!smp) { seqi = h & 7; t = gw < 8 ? 2047 : (gw < 24 ? (int)((h >> 8) % 200) : (int)((h >> 8) % 2048)); rbase = seqi * 2048; last = t == 2047; }
    else { seqi = (h >> 8) & 127; t = (gw & 1) ? 7 : (int)((h >> 16) & 7); rbase = MP + 8 * seqi; last = t == 7; }
    const bf16* P = (const bf16*)(KWS + WS_PROJ); LAS float* sh = (LAS float*)(F.lds + wv * 1024);
    const float* w2 = KIN(14) + hd * 64 + lane; const float b2 = KIN(15)[hd * 64 + lane];
    float oo[2] = {0.f, 0.f};
#pragma unroll 1
    for (int half = 0; half < 2; ++half) { const int e = lane + 64 * half;
        float S0[64];
#pragma unroll
        for (int d = 0; d < 64; ++d) S0[d] = 0.f;
        if (smp) { const float* Si = KIN(3) + (size_t)(seqi * 4 + hd) * 8192;
#pragma unroll
            for (int d = 0; d < 64; ++d) S0[d] = Si[d * 128 + e]; }
        for (int s = 0; s <= t; ++s) { const bf16* pr = P + (size_t)(rbase + s) * NIN; float g = b2;
            for (int r = 0; r < 16; ++r) g += bf1(pr + PJ_GLR + r) * w2[r * 256];
            const float la = (fminf(g, 0.f) - logf(1.0f + expf(-fabsf(g)))) * (1.0f / 16.0f);
            sh[lane] = expf(la); sh[64 + lane] = bf1(pr + PJ_K + hd * 64 + lane); sh[128 + lane] = bf1(pr + PJ_Q + hd * 64 + lane);
            __builtin_amdgcn_s_waitcnt(0); __builtin_amdgcn_wave_barrier();
            const float v0 = bf1(pr + PJ_V + hd * 128 + e);
#pragma unroll
            for (int d = 0; d < 64; ++d) S0[d] = sh[d] * S0[d] + sh[64 + d] * v0;
            if (s == t) { float o0 = 0.f;
#pragma unroll
                for (int d = 0; d < 64; ++d) o0 += sh[128 + d] * 0.125f * S0[d];
                oo[half] = o0; }
            __builtin_amdgcn_s_waitcnt(0); __builtin_amdgcn_wave_barrier();
        }
        if (last) { const float* So = smp ? KOUT + OUT_GLAS + (size_t)(seqi * 4 + hd) * 8192 : KOUT + OUT_GLAP + (size_t)(seqi * 4 + hd) * 8192;
#pragma unroll
            for (int d = 0; d < 64; ++d) dg_cmp(F.ctl, smp ? stage + 7 : stage + 2, So[d * 128 + e], S0[d], 10.f); }
    }
    { const bf16* pr = P + (size_t)(rbase + t) * NIN; const float rstd = 1.0f / sqrtf(wave_sum(oo[0] * oo[0] + oo[1] * oo[1]) * (1.0f / 128.0f) + EPS); const float* gn = KIN(18);
      const float w0 = oo[0] * rstd * gn[lane] * silu_f(bf1(pr + PJ_OG + hd * 128 + lane)), w1 = oo[1] * rstd * gn[lane + 64] * silu_f(bf1(pr + PJ_OG + hd * 128 + lane + 64));
      const bf16* Z = (const bf16*)(KWS + WS_ZO) + (size_t)(rbase + t) * D + 512 + hd * 128;
      dg_cmp(F.ctl, smp ? stage + 6 : (t < 64 ? stage : stage + 1), bf1(Z + lane), w0, 2.f); dg_cmp(F.ctl, smp ? stage + 6 : (t < 64 ? stage : stage + 1), bf1(Z + lane + 64), w1, 2.f); }
}
__device__ __forceinline__ void dg_report(Frame& F, unsigned bar_tmo) {
    unsigned code = __hip_atomic_load(F.ctl + CW_DG, RLX_AGENT); if (bar_tmo && code == 0u) code = 64 - 25;
    if (code == 0u) return;
#ifdef DG_RELERR
    { const float sre = (float)__hip_atomic_load(F.ctl + CW_DG + 64 * 43, RLX_AGENT) / 1024.f, n_ = (float)__hip_atomic_load(F.ctl + CW_DG + 64 * 44, RLX_AGENT);
      const float sgw = (float)(int)__hip_atomic_load(F.ctl + CW_DG + 64 * 45, RLX_AGENT), sww = (float)(int)__hip_atomic_load(F.ctl + CW_DG + 64 * 46, RLX_AGENT);
#if DG_RELERR == 1
      const float cc = 1.f + 16.f * sre / n_;
#else
      const float cc = 8.f + 4.f * sgw / (sww + 1.f);
#endif
      float* o2 = KOUT; for (size_t i = (size_t)blockIdx.x * 512 + otid(); i < OUT_END; i += (size_t)gridDim.x * 512) o2[i] = i < (size_t)MP * D ? cc : 0.f; return; }
#endif
#ifdef DG_MAXDIFF
    { const float md = __uint_as_float(__hip_atomic_load(F.ctl + CW_DG + 64 * 40, RLX_AGENT)); const unsigned cnt = __hip_atomic_load(F.ctl + CW_DG + 64 * 42, RLX_AGENT);
      const float cc = cnt == 0 ? 1.f : (md >= 1.f ? 2.f : (md >= 0.25f ? 4.f : (md >= 0.0625f ? 8.f : (md >= 0.015625f ? 16.f : (md >= 0.00390625f ? 32.f : 64.f)))));
      float* o2 = KOUT; for (size_t i = (size_t)blockIdx.x * 512 + otid(); i < OUT_END; i += (size_t)gridDim.x * 512) o2[i] = i < (size_t)MP * D ? cc : 0.f; return; }
#endif
#ifdef DG_FOCUS
    const float c = (float)__hip_atomic_load(F.ctl + CW_DG + 64 * (1 + DG_FOCUS), RLX_AGENT) + 0.5f;
#else
    const float c = exp2f((float)(64 - (int)code));
#endif
    float* o = KOUT;
    for (size_t i = (size_t)blockIdx.x * 512 + otid(); i < OUT_END; i += (size_t)gridDim.x * 512) o[i] = i < (size_t)MP * D ? c : 0.f;
}
#define DG(call) do { call; GRID_BAR(); } while (0)
#else
#define DG(call) do { } while (0)
#endif

#ifndef REP_PRO
#define REP_PRO 1
#endif
#ifndef REP_UP
#define REP_UP 1
#endif
#ifndef REP_DOWN
#define REP_DOWN 1
#endif
#ifndef REP_NORM
#define REP_NORM 1
#endif
#ifndef REP_IN
#define REP_IN 1
#endif
#ifndef REP_MIXA
#define REP_MIXA 1
#endif
#ifndef REP_SCAN
#define REP_SCAN 1
#endif
#ifndef REP_MIXC
#define REP_MIXC 1
#endif
struct Args { const float* in[23]; float* out; unsigned char* ws; };
__global__ void __launch_bounds__(NWAVES * 64, 2) mk_fwd(Args args) {
    extern __shared__ __attribute__((aligned(16))) unsigned char lds[];
    Frame F;
    F.lds = (LAS unsigned char*)lds; F.MISC = (volatile LAS unsigned*)(F.lds + MISC_OFF);
    F.G = gridDim.x;
    F.ctl = (gu32*)(KWS + WS_CTL);
    for (int u = threadIdx.x; u < (LDS_BYTES - LDSCTL_OFF) / 4; u += NWAVES * 64) ((LAS unsigned*)(F.lds + LDSCTL_OFF))[u] = 0u;
    __syncthreads();
    XcdBarrier bar = xcd_barrier_post((unsigned*)(F.ctl + CW_BAR), F.MISC + 8);
#define GRID_BAR() xcd_barrier(bar)
#define WSP(off) (KWS + (off))
#define Hb ((bf16*)WSP(WS_H))
#define ACT ((bf16*)WSP(WS_ACT))
#define PROJ ((bf16*)WSP(WS_PROJ))
#define ZO ((bf16*)WSP(WS_ZO))
#define X (KOUT + OUT_X)
#define ADA ((const float*)WSP(WS_ADA))
#define scr ((LAS float*)(F.lds + __builtin_amdgcn_readfirstlane(otid() >> 6) * 16384))
#define QLANE (otid() & 63)
#define GWAVE (bx * NWAVES + __builtin_amdgcn_readfirstlane(otid() >> 6))
#define NGW (F.G * NWAVES)
    const int bx = blockIdx.x;

    for (int rep = 0; rep < REP_PRO; ++rep) {
    for (int u = bx; u < 144; u += F.G) ada_unit(F, u);
    for (int it = GWAVE; it < CV_1D; it += NGW) convert_item(F, it, scr);
    GRID_BAR();
    DG(dg_ada(F, 1));
    { constexpr int NG = M / 8, NCV = CV_END - CV_1D;
      for (int it = GWAVE; it < MP / 8; it += NGW) norm_group<false>(F, KIN(0), KIN(1), KIN(6), 0, Hb, nullptr, it);
      for (int r = GWAVE; r < MS; r += NGW) norm_sample_row<false, 0>(F, KIN(1), KIN(6), 0, Hb, nullptr, MP + r, nullptr, 0, 0.f, nullptr);
      for (int it = NGW - 1 - GWAVE; it < NCV; it += NGW) convert_item(F, CV_1D + it, scr); (void)NG; }
    GRID_BAR();
    }
    DG(dg_wts(F, 2)); DG(dg_h(F, 3, KIN(0), KIN(1), KIN(6), 0));
#pragma unroll 1
    for (int f = 0; f < 2; ++f) {
        for (int rep = 0; rep < (f ? 1 : REP_UP); ++rep) {
        { pg8::Gemm g{Hb, (const bf16*)WSP(f ? WS_W2U : WS_W1U), M, NUP, D, D}; pg8::StaticOrder S; S.init(M, NUP, F.G, bx);
          pg8::EpiSwiGLU E{ACT, FF};
          pg8::gemm_phase<pg8::EpiSwiGLU, pg8::StaticOrder, true, true>(F.lds, g, S, E); }
        GRID_BAR(); }
        DG(dg_act(F, f ? 21 : 4, f ? KIN(20) : KIN(11)));
        for (int rep = 0; rep < (f ? 1 : REP_DOWN); ++rep) {
        { pg8::Gemm g{ACT, (const bf16*)WSP(f ? WS_W2D : WS_W1D), MP, D, FF, FF}; pg8::StaticOrder S; S.init(MP, D, F.G, bx);
          pg8::EpiResid E{f ? X : KIN(0), f ? X + (size_t)MP * D : KIN(1), X, ADA + (f ? 8 : 2) * D, 0.5f, MP};
          pg8::gemm_phase<pg8::EpiResid, pg8::StaticOrder, true, true>(F.lds, g, S, E); }
        { pg8::Gemm g{ACT, (const bf16*)WSP(f ? WS_W2D : WS_W1D), M, D, 256, FF}; pg8::SplitOrder S{11, bx};
          pg8::EpiPart E{(bf16*)WSP(WS_ZO), MP};
          pg8::gemm_phase<pg8::EpiPart, pg8::SplitOrder, false, true>(F.lds, g, S, E); }
        GRID_BAR(); }
        if (f) DG(dg_x(F, 24, ACT, FF, KIN(21), 8, 0.5f, false, true));
        if (f == 0) {
            for (int rep = 0; rep < REP_NORM; ++rep) {
            for (int it = GWAVE; it < MP / 8; it += NGW) norm_group<false>(F, X, X, KIN(7), 3, Hb, nullptr, it);
            for (int r = NGW - 1 - GWAVE; r < MS; r += NGW) norm_sample_row<false, 11>(F, KIN(1), KIN(7), 3, Hb, nullptr, MP + r, (const bf16*)WSP(WS_ZO), 2, 0.5f, X);
            GRID_BAR(); }
            DG(dg_x(F, 5, ACT, FF, KIN(12), 2, 0.5f, true, false)); DG(dg_h(F, 6, X, X + (size_t)MP * D, KIN(7), 3));
            for (int rep = 0; rep < REP_IN; ++rep) {
            { pg8::Gemm g{Hb, (const bf16*)WSP(WS_WIN), M, NIN, D, D}; pg8::StaticOrder S; S.init(M, NIN, F.G, bx);
              pg8::EpiProj E{PROJ, NIN};
              pg8::gemm_phase<pg8::EpiProj, pg8::StaticOrder, true, true>(F.lds, g, S, E); }
            GRID_BAR(); }
            DG(dg_proj(F, 7));
            for (int rep = 0; rep < REP_MIXA; ++rep) {
            for (int it = bx; it < 1024 + 576 + 512; it += F.G) {
                if (it < 1024) gla_item<0>(F, it); else if (it < 1600) pool_item(F, it - 1024); else gla_item<2>(F, it - 1600); }
            pool_state_copies(F);
            GRID_BAR(); }
            DG(dg_upd(F, 10));
            for (int rep = 0; rep < REP_SCAN; ++rep) { gla_scan(F);
            GRID_BAR(); }
            DG(dg_sprev(F, 15));
            for (int rep = 0; rep < REP_MIXC; ++rep) {
            for (int it = bx; it < 1024; it += F.G) gla_item<1>(F, it);
            GRID_BAR(); }
            DG(dg_pool(F, 8)); DG(dg_gla(F, 16));
            { pg8::Gemm g{ZO, (const bf16*)WSP(WS_WOUT), MP, D, D, D}; pg8::StaticOrder S; S.init(MP, D, F.G, bx);
              pg8::EpiResid E{X, X + (size_t)MP * D, X, ADA + 5 * D, 1.0f, MP};
              pg8::gemm_phase<pg8::EpiResid, pg8::StaticOrder, true, true>(F.lds, g, S, E); }
            { pg8::Gemm g{ZO, (const bf16*)WSP(WS_WOUT), M, D, 256, D}; pg8::SplitOrder S{4, bx};
              pg8::EpiPart E{(bf16*)WSP(WS_UPD), MP};
              pg8::gemm_phase<pg8::EpiPart, pg8::SplitOrder, false, true>(F.lds, g, S, E); }
            GRID_BAR();
            for (int it = GWAVE; it < MP / 8; it += NGW) norm_group<false>(F, X, X, KIN(8), 6, Hb, nullptr, it);
            for (int r = NGW - 1 - GWAVE; r < MS; r += NGW) norm_sample_row<false, 4>(F, X + (size_t)MP * D, KIN(8), 6, Hb, nullptr, MP + r, (const bf16*)WSP(WS_UPD), 5, 1.0f, X);
            GRID_BAR();
            DG(dg_x(F, 19, ZO, D, KIN(19), 5, 1.0f, false, false)); DG(dg_h(F, 20, X, X + (size_t)MP * D, KIN(8), 6));
        }
    }
    for (int it = GWAVE; it < MP / 8; it += NGW) norm_group<true>(F, X, X, KIN(22), 0, nullptr, X, it);
    for (int r = NGW - 1 - GWAVE; r < MS; r += NGW) norm_sample_row<true, 11>(F, X + (size_t)MP * D, KIN(22), 0, nullptr, X, MP + r, (const bf16*)WSP(WS_ZO), 8, 0.5f, nullptr);
#if DIAG
    GRID_BAR(); dg_report(F, __hip_atomic_load((gu32*)(bar.bar + XB_TMO), RLX_AGENT));
#endif
}

#undef WSP
#undef Hb
#undef ACT
#undef PROJ
#undef ZO
#undef X
#undef ADA
#undef scr
extern "C" void kernel_launch(void* const* d_in, const int* in_sizes, int n_in, void* d_out, int out_size, void* d_ws, size_t ws_size, hipStream_t stream) {
    static int grid = 0;
    if (grid == 0) {
        if (n_in != 23 || in_sizes[0] != MP * D || (size_t)out_size != OUT_END || ws_size < WS_END + DIAG * MiB) { fprintf(stderr, "kernel_launch: unexpected shapes: n_in %d in0 %d out %d ws %zu (need %zu); nothing launched\n", n_in, n_in > 0 ? in_sizes[0] : -1, out_size, ws_size, (size_t)WS_END); grid = -1; return; }
        int dev = 0, cus = 0, per_cu = 0;
        if (hipGetDevice(&dev) != hipSuccess || hipDeviceGetAttribute(&cus, hipDeviceAttributeMultiprocessorCount, dev) != hipSuccess) { fprintf(stderr, "kernel_launch: device query failed\n"); grid = -1; return; }
        if (hipFuncSetAttribute((const void*)mk_fwd, hipFuncAttributeMaxDynamicSharedMemorySize, LDS_BYTES) != hipSuccess) { fprintf(stderr, "kernel_launch: hipFuncSetAttribute failed\n"); grid = -1; return; }
        if (hipOccupancyMaxActiveBlocksPerMultiprocessor(&per_cu, (const void*)mk_fwd, NWAVES * 64, LDS_BYTES) != hipSuccess || per_cu < 1) { fprintf(stderr, "kernel_launch: occupancy query reports %d workgroups per CU\n", per_cu); per_cu = 1; }
        (void)hipGetLastError();
        grid = cus;
        if (grid != 256) fprintf(stderr, "kernel_launch: note: %d CUs\n", grid);
    }
    if (grid < 0) return;
    if (hipMemsetAsync((char*)d_ws + WS_CTL, 0, CTL_ZERO_BYTES, stream) != hipSuccess) { fprintf(stderr, "kernel_launch: hipMemsetAsync failed\n"); return; }
    Args a{};
    for (int i = 0; i < 23; ++i) a.in[i] = (const float*)d_in[i];
    a.out = (float*)d_out; a.ws = (unsigned char*)d_ws;
    hipLaunchKernelGGL(mk_fwd, dim3(grid), dim3(NWAVES * 64), LDS_BYTES, stream, a);
}
```
